# Optimizing an MI355X kernel written in HIP

```python
import jax
import jax.numpy as jnp
from jax import lax
import numpy as np

D_MODEL = 1024
BATCH = 16
SEQ = 4096
DEPTH = 4

CTX_LEN = 256
GRID_W = 64
D_A = D_MODEL // 4
H_A = 4
DH_A = D_A // H_A
CHUNK = 128
D_B = D_MODEL // 4
H_B = 4
DH_B = D_B // H_B
CONV_W = 4
LRU_C = 8.0
H_C = 8
D_V = D_MODEL // (2 * H_C)
D_NOPE = D_V
D_ROPE = D_V // 2
D_QK = D_NOPE + D_ROPE
Q_LORA = 3 * D_MODEL // 8
KV_LORA = D_MODEL // 4
Q_BLOCK = 128
ROPE_BASE = 10000.0
D_C = H_C * D_V
D_MIX = D_A + D_B + D_C
D_IN = 2 * D_A + 2 * D_B + Q_LORA + KV_LORA + D_ROPE
D_FF = ((8 * D_MODEL // 3 + 127) // 128) * 128
N_EXPERTS = 8
TOP_K = 2
D_FF_EXPERT = 7 * D_MODEL // 2
MOE_BLOCK = 128
EPS = 1e-6
N_DENSE = (DEPTH + 1) // 2
N_MOE = DEPTH // 2

kernel_name = "hybrid_sgu_rglru_mla_moe_dit"


def _rmsnorm(x, g):
    xf = x.astype(jnp.float32)
    y = xf * lax.rsqrt(jnp.mean(xf * xf, axis=-1, keepdims=True) + EPS)
    return (y * g.astype(jnp.float32)).astype(x.dtype)


def _layernorm(x, g, b):
    xf = x.astype(jnp.float32)
    mu = jnp.mean(xf, axis=-1, keepdims=True)
    xc = xf - mu
    var = jnp.mean(xc * xc, axis=-1, keepdims=True)
    return (xc * lax.rsqrt(var + EPS) * g.astype(jnp.float32) + b.astype(jnp.float32)).astype(x.dtype)


def _modulation(cond, w_mod, b_mod):
    return jnp.split(jax.nn.silu(cond) @ w_mod + b_mod, 6, axis=-1)


def _modulate(xn, shift, scale):
    return xn * (1.0 + scale) + shift


def _chunk_sgu(z, ln_g, ln_b, w_s, b_s):
    bsz, L, _ = z.shape
    u, v = jnp.split(jax.nn.gelu(z), 2, axis=-1)
    v = _layernorm(v, ln_g, ln_b).reshape(bsz, L // CHUNK, CHUNK, H_A, DH_A)
    s = jnp.einsum('hpq,bnqhd->bnphd', w_s, v) + b_s.T[:, :, None]
    return u * s.reshape(bsz, L, D_A)


def _dwconv(x, w, b):
    c = x.shape[-1]
    y = lax.conv_general_dilated(
        x, w[:, None, :].astype(x.dtype), window_strides=(1,),
        padding=[(CONV_W // 2, CONV_W - 1 - CONV_W // 2)],
        dimension_numbers=('NWC', 'WIO', 'NWC'), feature_group_count=c)
    return y + b


def _rglru_coeffs(x, w_a, b_a, w_x, b_x, lam):
    bsz, L, _ = x.shape
    xh = x.reshape(bsz, L, H_B, DH_B)
    r = jax.nn.sigmoid(jnp.einsum('blhi,hij->blhj', xh, w_a).reshape(bsz, L, D_B) + b_a)
    i = jax.nn.sigmoid(jnp.einsum('blhi,hij->blhj', xh, w_x).reshape(bsz, L, D_B) + b_x)
    log_a = (-LRU_C * r.astype(jnp.float32)) * jax.nn.softplus(-lam.astype(jnp.float32))
    a = jnp.exp(log_a)
    bval = jnp.sqrt(-jnp.expm1(2.0 * log_a)) * (i * x).astype(jnp.float32)
    return a, bval


def _linear_scan(a, b, h0, reverse):
    def combine(lhs, rhs):
        return lhs[0] * rhs[0], rhs[0] * lhs[1] + rhs[1]
    a_cum, b_cum = lax.associative_scan(combine, (a, b), reverse=reverse, axis=1)
    return b_cum + a_cum * h0[:, None, :]


def _rotate(x, cos, sin):
    x1, x2 = jnp.split(x, 2, axis=-1)
    cos = cos[:, None, :]
    sin = sin[:, None, :]
    return jnp.concatenate([x1 * cos - x2 * sin, x1 * sin + x2 * cos], axis=-1)


def _rope_2d(x, rope):
    cos_r, sin_r, cos_c, sin_c = rope
    x_row, x_col = jnp.split(x.astype(jnp.float32), 2, axis=-1)
    y = jnp.concatenate([_rotate(x_row, cos_r, sin_r), _rotate(x_col, cos_c, sin_c)], axis=-1)
    return y.astype(x.dtype)


def _mla_queries(zm, q_norm, w_uq):
    bsz, L, _ = zm.shape
    cq = _rmsnorm(zm[..., :Q_LORA], q_norm)
    return (cq @ w_uq).reshape(bsz, L, H_C, D_QK)


def _mla_keys_values(zm, kv_norm, w_uk, w_uv, rope):
    bsz, L, _ = zm.shape
    ckv = _rmsnorm(zm[..., Q_LORA:Q_LORA + KV_LORA], kv_norm)
    k_rope = zm[..., Q_LORA + KV_LORA:][:, :, None, :]
    if rope is not None:
        k_rope = _rope_2d(k_rope, rope)
    k_nope = (ckv @ w_uk).reshape(bsz, L, H_C, D_NOPE)
    v = (ckv @ w_uv).reshape(bsz, L, H_C, D_V)
    k = jnp.concatenate([k_nope, jnp.broadcast_to(k_rope, (bsz, L, H_C, D_ROPE))], axis=-1)
    return k, v


def _attend(q, k, v):
    s = jnp.einsum('bqhd,bkhd->bhqk', q, k).astype(jnp.float32) * (D_QK ** -0.5)
    p = jax.nn.softmax(s, axis=-1).astype(v.dtype)
    return jnp.einsum('bhqk,bkhd->bqhd', p, v)


def _latent_attention(q, k, v):
    bsz, L = q.shape[:2]
    qb = q.reshape(bsz, L // Q_BLOCK, Q_BLOCK, H_C, D_QK).transpose(1, 0, 2, 3, 4)
    o = lax.map(lambda qi: _attend(qi, k, v), qb)
    return o.transpose(1, 0, 2, 3, 4).reshape(bsz, L, D_C)


def _mixer(h, hc, rope, last, w_in, w_out, sgu_ln_g, sgu_ln_b, sgu_w, sgu_b,
           conv_w, conv_b, lru_w_a, lru_b_a, lru_w_x, lru_b_x, lru_lam,
           q_norm, w_uq, kv_norm, w_uk, w_uv):
    bsz, L, _ = h.shape
    cuts = [2 * D_A, 2 * D_A + 2 * D_B]
    za, zb, zm = jnp.split(h @ w_in, cuts, axis=-1)
    za_c, zb_c, zm_c = jnp.split(hc @ w_in, cuts, axis=-1)

    y_a = _chunk_sgu(za, sgu_ln_g, sgu_ln_b, sgu_w, sgu_b)

    g_b, x_b = jnp.split(zb, 2, axis=-1)
    g_bc, x_bc = jnp.split(zb_c, 2, axis=-1)
    x_b = _dwconv(x_b, conv_w, conv_b)
    x_bc = _dwconv(x_bc, conv_w, conv_b)
    h_lat = jnp.zeros((bsz, L, D_B), jnp.float32)
    ctx_states = []
    for d, rev in enumerate((False, True)):
        gates = (lru_w_a[d], lru_b_a[d], lru_w_x[d], lru_b_x[d], lru_lam[d])
        a_c, b_c = _rglru_coeffs(x_bc, *gates)
        hs_c = _linear_scan(a_c, b_c, jnp.zeros((bsz, D_B), jnp.float32), rev)
        h_end = hs_c[:, 0] if rev else hs_c[:, -1]
        a_l, b_l = _rglru_coeffs(x_b, *gates)
        h_lat = h_lat + _linear_scan(a_l, b_l, h_end, rev)
        ctx_states.append(hs_c)
    y_b = jax.nn.gelu(g_b) * h_lat.astype(h.dtype)

    q = _mla_queries(zm, q_norm, w_uq)
    q = jnp.concatenate([q[..., :D_NOPE], _rope_2d(q[..., D_NOPE:], rope)], axis=-1)
    k, v = _mla_keys_values(zm, kv_norm, w_uk, w_uv, rope)
    k_c, v_c = _mla_keys_values(zm_c, kv_norm, w_uk, w_uv, None)
    y_c = _latent_attention(q, jnp.concatenate([k, k_c], axis=1), jnp.concatenate([v, v_c], axis=1))

    y = jnp.concatenate([y_a, y_b, y_c], axis=-1) @ w_out
    if last:
        return y, None

    lc = hc.shape[1]
    y_ac = _chunk_sgu(za_c, sgu_ln_g, sgu_ln_b, sgu_w, sgu_b)
    y_bc = jax.nn.gelu(g_bc) * (ctx_states[0] + ctx_states[1]).astype(hc.dtype)
    q_c = _mla_queries(zm_c, q_norm, w_uq)
    y_cc = _attend(q_c, k_c, v_c).reshape(bsz, lc, D_C)
    y_ctx = jnp.concatenate([y_ac, y_bc, y_cc], axis=-1) @ w_out
    return y, y_ctx


def _swiglu(h, w1, w3, w2):
    return (jax.nn.silu(h @ w1) * (h @ w3)) @ w2


def _moe_swiglu(h, w_router, w1, w3, w2):
    n, d = h.shape
    logits = h.astype(jnp.float32) @ w_router.astype(jnp.float32)
    top_v, top_e = lax.top_k(logits, TOP_K)
    gates = jax.nn.softmax(top_v, axis=-1)
    n_assign = n * TOP_K
    e_flat = top_e.reshape(-1).astype(jnp.int32)
    tok_flat = jnp.repeat(jnp.arange(n, dtype=jnp.int32), TOP_K)
    g_flat = gates.reshape(-1)
    order = jnp.argsort(e_flat)
    e_sorted = e_flat[order]
    counts = jnp.bincount(e_flat, length=N_EXPERTS).astype(jnp.int32)
    starts = jnp.cumsum(counts) - counts
    padded = (counts + MOE_BLOCK - 1) // MOE_BLOCK * MOE_BLOCK
    pad_ends = jnp.cumsum(padded)
    pad_starts = pad_ends - padded
    dest = pad_starts[e_sorted] + jnp.arange(n_assign, dtype=jnp.int32) - starts[e_sorted]
    n_pad = ((n_assign + MOE_BLOCK - 1) // MOE_BLOCK + N_EXPERTS) * MOE_BLOCK
    n_blk = n_pad // MOE_BLOCK
    tok_pad = jnp.full((n_pad,), n, jnp.int32).at[dest].set(tok_flat[order])
    gate_pad = jnp.zeros((n_pad,), jnp.float32).at[dest].set(g_flat[order])
    blk_e = jnp.minimum(jnp.searchsorted(pad_ends, jnp.arange(n_blk, dtype=jnp.int32) * MOE_BLOCK, side='right'),
                        N_EXPERTS - 1)
    h_ext = jnp.concatenate([h, jnp.zeros((1, d), h.dtype)], axis=0)
    h_blk = h_ext[tok_pad].reshape(n_blk, MOE_BLOCK, d)

    def expert_group(args):
        hb, e = args
        return (jax.nn.silu(hb @ w1[e]) * (hb @ w3[e])) @ w2[e]

    y_pad = lax.map(expert_group, (h_blk, blk_e)).reshape(n_pad, d)
    y = jnp.zeros((n + 1, d), h.dtype).at[tok_pad].add((y_pad * gate_pad[:, None]).astype(h.dtype))
    return y[:n]


def setup_inputs(seed: int = 0) -> dict:
    key = jax.random.key(seed)
    ks = iter(jax.random.split(key, 40))
    f32 = jnp.float32

    def nrm(shape, fan_in, scale=1.0):
        return jax.random.normal(next(ks), shape, f32) * (scale * fan_in ** -0.5)

    def gain(shape):
        return 1.0 + 0.05 * jax.random.normal(next(ks), shape, f32)

    def bias(shape, s=0.02):
        return s * jax.random.normal(next(ks), shape, f32)

    u = jax.random.uniform(next(ks), (DEPTH, 2, D_B), f32, 0.9, 0.999)
    a_base = u ** (1.0 / LRU_C)
    lam = jnp.log(a_base) - jnp.log1p(-a_base)

    return {
        "x": jax.random.normal(next(ks), (BATCH, SEQ, D_MODEL), f32),
        "c": jax.random.normal(next(ks), (BATCH, D_MODEL), f32),
        "ctx": jax.random.normal(next(ks), (BATCH, CTX_LEN, D_MODEL), f32),
        "c_ctx": jax.random.normal(next(ks), (D_MODEL,), f32),
        "w_mod": nrm((DEPTH, D_MODEL, 6 * D_MODEL), D_MODEL, 0.3),
        "b_mod": bias((DEPTH, 6 * D_MODEL)),
        "norm1_g": gain((DEPTH, D_MODEL)),
        "norm2_g": gain((DEPTH, D_MODEL)),
        "w_in": nrm((DEPTH, D_MODEL, D_IN), D_MODEL),
        "w_out": nrm((DEPTH, D_MIX, D_MODEL), D_MIX),
        "sgu_ln_g": gain((DEPTH, D_A)),
        "sgu_ln_b": bias((DEPTH, D_A)),
        "sgu_w": nrm((DEPTH, H_A, CHUNK, CHUNK), CHUNK, 0.5),
        "sgu_b": gain((DEPTH, H_A, CHUNK)),
        "conv_w": nrm((DEPTH, CONV_W, D_B), CONV_W),
        "conv_b": bias((DEPTH, D_B)),
        "lru_w_a": nrm((DEPTH, 2, H_B, DH_B, DH_B), DH_B),
        "lru_b_a": bias((DEPTH, 2, D_B)),
        "lru_w_x": nrm((DEPTH, 2, H_B, DH_B, DH_B), DH_B),
        "lru_b_x": bias((DEPTH, 2, D_B)),
        "lru_lam": lam,
        "mla_q_norm": gain((DEPTH, Q_LORA)),
        "mla_w_uq": nrm((DEPTH, Q_LORA, H_C * D_QK), Q_LORA),
        "mla_kv_norm": gain((DEPTH, KV_LORA)),
        "mla_w_uk": nrm((DEPTH, KV_LORA, H_C * D_NOPE), KV_LORA),
        "mla_w_uv": nrm((DEPTH, KV_LORA, H_C * D_V), KV_LORA),
        "ffn_w1": nrm((N_DENSE, D_MODEL, D_FF), D_MODEL),
        "ffn_w3": nrm((N_DENSE, D_MODEL, D_FF), D_MODEL),
        "ffn_w2": nrm((N_DENSE, D_FF, D_MODEL), D_FF),
        "moe_router": nrm((N_MOE, D_MODEL, N_EXPERTS), D_MODEL),
        "moe_w1": nrm((N_MOE, N_EXPERTS, D_MODEL, D_FF_EXPERT), D_MODEL),
        "moe_w3": nrm((N_MOE, N_EXPERTS, D_MODEL, D_FF_EXPERT), D_MODEL),
        "moe_w2": nrm((N_MOE, N_EXPERTS, D_FF_EXPERT, D_MODEL), D_FF_EXPERT),
        "final_norm_g": gain((D_MODEL,)),
    }


def reference(x, c, ctx, c_ctx, w_mod, b_mod, norm1_g, norm2_g, w_in, w_out,
              sgu_ln_g, sgu_ln_b, sgu_w, sgu_b, conv_w, conv_b,
              lru_w_a, lru_b_a, lru_w_x, lru_b_x, lru_lam,
              mla_q_norm, mla_w_uq, mla_kv_norm, mla_w_uk, mla_w_uv,
              ffn_w1, ffn_w3, ffn_w2, moe_router, moe_w1, moe_w3, moe_w2,
              final_norm_g):
    bsz, L, d = x.shape
    lc = ctx.shape[1]
    rows = L // GRID_W
    row = jnp.repeat(jnp.arange(rows, dtype=jnp.float32), GRID_W)
    col = jnp.tile(jnp.arange(GRID_W, dtype=jnp.float32), rows)
    inv_freq = ROPE_BASE ** (-jnp.arange(0, D_ROPE // 2, 2, dtype=jnp.float32) / (D_ROPE // 2))
    ang_r = row[:, None] * inv_freq
    ang_c = col[:, None] * inv_freq
    rope = (jnp.cos(ang_r), jnp.sin(ang_r), jnp.cos(ang_c), jnp.sin(ang_c))

    xc = ctx
    for l in range(DEPTH):
        last = l == DEPTH - 1
        sh1, sc1, g1, sh2, sc2, g2 = _modulation(c, w_mod[l], b_mod[l])
        sh1c, sc1c, g1c, sh2c, sc2c, g2c = _modulation(c_ctx, w_mod[l], b_mod[l])

        h = _modulate(_rmsnorm(x, norm1_g[l]), sh1[:, None], sc1[:, None])
        hc = _modulate(_rmsnorm(xc, norm1_g[l]), sh1c, sc1c)
        y, y_ctx = _mixer(h, hc, rope, last, w_in[l], w_out[l],
                          sgu_ln_g[l], sgu_ln_b[l], sgu_w[l], sgu_b[l],
                          conv_w[l], conv_b[l], lru_w_a[l], lru_b_a[l], lru_w_x[l], lru_b_x[l], lru_lam[l],
                          mla_q_norm[l], mla_w_uq[l], mla_kv_norm[l], mla_w_uk[l], mla_w_uv[l])
        x = x + g1[:, None] * y
        if not last:
            xc = xc + g1c * y_ctx

        h = _modulate(_rmsnorm(x, norm2_g[l]), sh2[:, None], sc2[:, None])
        if l % 2 == 0:
            i = l // 2
            x = x + g2[:, None] * _swiglu(h, ffn_w1[i], ffn_w3[i], ffn_w2[i])
            if not last:
                hc = _modulate(_rmsnorm(xc, norm2_g[l]), sh2c, sc2c)
                xc = xc + g2c * _swiglu(hc, ffn_w1[i], ffn_w3[i], ffn_w2[i])
        else:
            i = l // 2
            tok = h.reshape(bsz * L, d)
            if not last:
                hc = _modulate(_rmsnorm(xc, norm2_g[l]), sh2c, sc2c)
                tok = jnp.concatenate([tok, hc.reshape(bsz * lc, d)], axis=0)
            f = _moe_swiglu(tok, moe_router[i], moe_w1[i], moe_w3[i], moe_w2[i])
            x = x + g2[:, None] * f[:bsz * L].reshape(bsz, L, d)
            if not last:
                xc = xc + g2c * f[bsz * L:].reshape(bsz, lc, d)

    return _rmsnorm(x, final_norm_g)
```

```cpp
#include <hip/hip_runtime.h>
#include <cstdio>
#include <cstdint>

#ifndef DOWN_FP8
#define DOWN_FP8 0
#endif
#ifndef W_IN_I8
#define W_IN_I8 1
#endif
#ifndef CHECK
#define CHECK 0
#endif

#define LAS __attribute__((address_space(3)))
typedef unsigned short bf16_t;
typedef short bf16x8 __attribute__((ext_vector_type(8)));
typedef short s16x4 __attribute__((ext_vector_type(4)));
typedef float f32x4 __attribute__((ext_vector_type(4)));
typedef float f32x2 __attribute__((ext_vector_type(2)));
typedef float f32x16 __attribute__((ext_vector_type(16)));
typedef unsigned u32x4 __attribute__((ext_vector_type(4)));
typedef unsigned u32x2 __attribute__((ext_vector_type(2)));
typedef int i32x4 __attribute__((ext_vector_type(4)));
typedef int i32x8 __attribute__((ext_vector_type(8)));

constexpr int NB = 16, SEQ = 4096, LC = 256, DM = 1024, DEPTH = 4;
constexpr int NLAT = NB * SEQ, NCTX = NB * LC, NTOK = NLAT + NCTX;
constexpr int D_IN = 1696, ZP = 1792;
constexpr int ZU = 0, ZV = 256, ZG = 512, ZX = 768, ZQ = 1024, ZKV = 1408, ZR = 1664;
constexpr int QLORA = 384, KVLORA = 256, QP = 768, KVP = 1024, HC = 8, DQK = 96;
constexpr int DFF = 2816, DFE = 3584, NE = 8;
constexpr int NSEG = 136;
constexpr float EPS = 1e-6f;
constexpr int NWAVES = 8, NTHR = 512;

enum { I_X = 0, I_C, I_CTX, I_CCTX, I_WMOD, I_BMOD, I_N1G, I_N2G, I_WIN, I_WOUT, I_SLNG, I_SLNB, I_SGUW, I_SGUB, I_CONVW, I_CONVB,
       I_LWA, I_LBA, I_LWX, I_LBX, I_LAM, I_QN, I_WUQ, I_KVN, I_WUK, I_WUV, I_F1, I_F3, I_F2, I_ROUT, I_M1, I_M3, I_M2, I_FNG, N_IN };

constexpr size_t al256(size_t x) { return (x + 255) / 256 * 256; }
constexpr size_t WS_CTL = 0, CTL_BYTES = 1u << 20;
constexpr size_t WS_MOD = WS_CTL + CTL_BYTES;
constexpr size_t WS_ROPE = WS_MOD + al256((size_t)DEPTH * 17 * 6144 * 4);
constexpr size_t WS_C8 = WS_ROPE + al256(64 * 8 * 2 * 4);
constexpr size_t WS_SSP = WS_C8 + al256(DEPTH * 2 * 256 * 4);
constexpr size_t WS_AGG = WS_SSP + al256((size_t)NTOK * 16 * 4);
constexpr size_t WS_CARRY = WS_AGG + al256((size_t)NB * NSEG * 2 * 256 * 8);
constexpr size_t WS_TOPE = WS_CARRY + al256((size_t)NB * NSEG * 2 * 256 * 4);
constexpr size_t WS_TOPG = WS_TOPE + al256((size_t)NTOK * 16);
constexpr size_t WS_LIST = WS_TOPG + al256((size_t)NTOK * 8);
constexpr size_t WS_RSC = WS_LIST + al256((size_t)NE * NTOK * 4);
constexpr size_t WS_HS = WS_RSC + al256((size_t)NE * NTOK * 4);
constexpr size_t WS_WSC = WS_HS + al256((size_t)NTOK * 4);
constexpr size_t WSC_IN = 0, WSC_FF = (size_t)DEPTH * ZP * 4, WSC_MO = WSC_FF + (size_t)2 * 2 * DFF * 4, WSC_F2 = WSC_MO + (size_t)NE * 2 * DFE * 4  , WSC_M2 = WSC_F2 + (size_t)2 * DM * 4  ,
                 WSC_BYTES = al256(WSC_M2 + (size_t)NE * DM * 4);
constexpr size_t WS_XB = WS_WSC + WSC_BYTES;
constexpr size_t WS_K8 = WS_XB + al256((size_t)NTOK * DM * 2);
constexpr size_t WS_R8 = WS_K8 + al256((size_t)NTOK * 512);
constexpr size_t WS_VT8 = WS_R8 + al256((size_t)NTOK * 32);
constexpr size_t WS_WSM = WS_VT8 + al256((size_t)NTOK * 512);
constexpr size_t SM_IN = 0, SM_OUT = SM_IN + (size_t)ZP * DM * 2, SM_Q = SM_OUT + (size_t)DM * DM * 2, SM_KV = SM_Q + (size_t)QP * QLORA * 2,
                 SM_SGU = SM_KV + (size_t)KVP * KVLORA * 2, SM_GW = SM_SGU + (size_t)4 * 128 * 128 * 2, SM_BYTES = al256(SM_GW + (size_t)2 * 2 * 4 * 64 * 64 * 2);
constexpr size_t WS_FFN = WS_WSM + DEPTH * SM_BYTES;
constexpr size_t FF_13 = 0, FF_2 = (size_t)2 * DFF * DM * 2, FF_BYTES = FF_2 + (size_t)DM * DFF * 2;
constexpr size_t WS_MOE = WS_FFN + 2 * FF_BYTES;
constexpr size_t MO_13 = 0, MO_2 = (size_t)NE * 2 * DFE * DM * 2, MO_BYTES = MO_2 + (size_t)NE * DM * DFE * 2;
constexpr size_t WS_H = WS_MOE + MO_BYTES;
constexpr size_t WS_BIG = WS_H + (size_t)NTOK * DM * (W_IN_I8 ? 1 : 2);
constexpr size_t BG_ZIN = 0, BG_Q = BG_ZIN + (size_t)NTOK * ZP * 2, BG_KV = BG_Q + (size_t)NTOK * QP * 2, BG_MIX = BG_KV + (size_t)NTOK * KVP * 2,
                 BG_BYTES = BG_MIX + (size_t)NTOK * DM * 2;
constexpr int MOE_RT = 192;
constexpr size_t BG_HMID = 0, BG_YPAD = (size_t)MOE_RT * 256 * DFE * 2;
constexpr int MOE_MAXT = (2 * NTOK) / 256 + NE;
constexpr int MOE_NR = (MOE_MAXT + MOE_RT - 1) / MOE_RT;
static_assert(BG_YPAD + (size_t)MOE_MAXT * 256 * DM * 2 <= BG_BYTES, "YPAD fits");
static_assert((size_t)NTOK * DFF * 2 <= BG_BYTES, "dense HMID fits");
constexpr size_t WS_END = WS_BIG + BG_BYTES;
static_assert(WS_END < 1200000000ull, "workspace budget");

constexpr int CW_BAR = 4096;
constexpr int CW_CNT = 8192;
constexpr int CW_CARRY = 12288;
constexpr int CW_P2 = 13312;
constexpr int CW_CHK = 16384;

__device__ __forceinline__ float bf2f(bf16_t v) { return __uint_as_float(((unsigned)v) << 16); }
__device__ __forceinline__ unsigned cvt_pk_bf16(float lo, float hi) { unsigned r; asm volatile("v_cvt_pk_bf16_f32 %0, %1, %2" : "=v"(r) : "v"(lo), "v"(hi)); return r; }
__device__ __forceinline__ bf16_t f2bf(float f) { return (bf16_t)(cvt_pk_bf16(f, 0.f) & 0xffffu); }
__device__ __forceinline__ float fast_exp2(float x) { return __builtin_amdgcn_exp2f(x); }
__device__ __forceinline__ float fast_rcp(float x) { return __builtin_amdgcn_rcpf(x); }
__device__ __forceinline__ float sigmoid_f(float x) { return fast_rcp(1.0f + fast_exp2(-1.4426950408889634f * x)); }
__device__ __forceinline__ float silu_f(float x) { return x * sigmoid_f(x); }
__device__ __forceinline__ float gelu_tanh_f(float x) { const float u = 0.7978845608028654f * (x + 0.044715f * x * x * x); return x * sigmoid_f(2.0f * u); }
#define DPP_F(v, ctrl) __builtin_bit_cast(float, __builtin_amdgcn_update_dpp(0, __builtin_bit_cast(int, (v)), (ctrl), 0xf, 0xf, true))
__device__ __forceinline__ float xor16_f(float v) { return __builtin_bit_cast(float, __builtin_amdgcn_ds_swizzle(__builtin_bit_cast(int, v), 0x401f)); }
__device__ __forceinline__ void pl32swap(unsigned& a, unsigned& b) { asm volatile("s_nop 1\n\tv_permlane32_swap_b32 %0, %1\n\ts_nop 0" : "+v"(a), "+v"(b)); }
__device__ __forceinline__ float xor32_f(float v) {
    unsigned a = __builtin_bit_cast(unsigned, v), b = a; pl32swap(a, b);
    return (__builtin_amdgcn_mbcnt_hi(~0u, __builtin_amdgcn_mbcnt_lo(~0u, 0u)) < 32u) ? __builtin_bit_cast(float, b) : __builtin_bit_cast(float, a);
}
__device__ __forceinline__ float sum32_f(float v) {
    unsigned a = __builtin_bit_cast(unsigned, v), b = a; pl32swap(a, b);
    return __builtin_bit_cast(float, a) + __builtin_bit_cast(float, b);
}
__device__ __forceinline__ float max32_f(float v) {
    unsigned a = __builtin_bit_cast(unsigned, v), b = a; pl32swap(a, b);
    return fmaxf(__builtin_bit_cast(float, a), __builtin_bit_cast(float, b));
}
__device__ __forceinline__ float wave_max(float v) {
    v = fmaxf(v, DPP_F(v, 0xB1)); v = fmaxf(v, DPP_F(v, 0x4E)); v = fmaxf(v, DPP_F(v, 0x141)); v = fmaxf(v, DPP_F(v, 0x140));
    v = fmaxf(v, xor16_f(v));
    return max32_f(v);
}
__device__ __forceinline__ float wave_sum(float v) {
    v += DPP_F(v, 0xB1);
    v += DPP_F(v, 0x4E);
    v += DPP_F(v, 0x141);
    v += DPP_F(v, 0x140);
    v += xor16_f(v);
    return sum32_f(v);
}
__device__ __forceinline__ int crow(int r, int hi) { return (r & 3) + 8 * (r >> 2) + 4 * hi; }

#define XB_TMO      128
#define XB_XCNT(j)  (256  + 64 * (j))
#define XB_XSUB(j)  (1280 + 64 * (j))
#define XB_XGEN(j)  (2304 + 64 * (j))
#define XB_TOP      3328
#define XB_TOPGEN   3392
#define XCD_BAR_WORDS 3456
#define XB_SPIN_CAP (1u << 22)
__device__ __forceinline__ unsigned xb_ld(unsigned* p)              { return __hip_atomic_load(p, __ATOMIC_RELAXED, __HIP_MEMORY_SCOPE_AGENT); }
__device__ __forceinline__ unsigned xb_add(unsigned* p, unsigned v) { return __hip_atomic_fetch_add(p, v, __ATOMIC_RELAXED, __HIP_MEMORY_SCOPE_AGENT); }
__device__ __forceinline__ unsigned xb_xcc_id() { return (unsigned)__builtin_amdgcn_s_getreg((3 << 11) | 20) & 0xFu; }
#define XB_SPIN(cond, bar) do { unsigned _sp = 0; while (cond) { __builtin_amdgcn_s_sleep(1); \
    if ((++_sp & 255u) == 0u) { if (xb_ld(&(bar)[XB_TMO])) break; if (_sp > XB_SPIN_CAP) { atomicAdd(&(bar)[XB_TMO], 1u); break; } } } } while (0)
struct XcdBarrier { unsigned* bar; unsigned x; volatile LAS unsigned* st; };
__device__ __forceinline__ XcdBarrier xcd_barrier_post(unsigned* bar, volatile LAS unsigned* st) {
    XcdBarrier b; b.bar = bar; b.x = xb_xcc_id(); b.st = st;
    if (threadIdx.x == 0) (void)xb_add(&bar[XB_XCNT(b.x)], 1u);
    return b;
}
__device__ __forceinline__ void xcd_barrier_complete(unsigned* bar, unsigned x, unsigned& nloc, unsigned& nx) {
    const unsigned G = gridDim.x * gridDim.y * gridDim.z;
    unsigned sum, cnt, mine, sp = 0u;
    for (;;) {
        sum = 0u; cnt = 0u; mine = 0u;
#pragma unroll
        for (unsigned j = 0; j < 16; ++j) { const unsigned c = xb_ld(&bar[XB_XCNT(j)]); sum += c; cnt += (c > 0u) ? 1u : 0u; }
        if (sum == G) { mine = xb_ld(&bar[XB_XCNT(x)]); break; }
        __builtin_amdgcn_s_sleep(1);
        if ((++sp & 255u) == 0u) { if (xb_ld(&bar[XB_TMO])) break; if (sp > XB_SPIN_CAP) { atomicAdd(&bar[XB_TMO], 1u); break; } }
    }
    nloc = mine > 0u ? mine : 1u; nx = cnt > 0u ? cnt : 1u;
}
__device__ __forceinline__ void xcd_barrier(const XcdBarrier& b) {
    asm volatile("s_waitcnt vmcnt(0)" ::: "memory");
    __syncthreads();
    if (threadIdx.x == 0) {
        unsigned* bar = b.bar; asm volatile("" : "+s"(bar));
        __builtin_amdgcn_s_waitcnt(0);
        unsigned nloc = b.st[0], nx = b.st[1];
        if (nloc == 0u) { xcd_barrier_complete(bar, b.x, nloc, nx); b.st[0] = nloc; b.st[1] = nx; }
        const unsigned old = xb_add(&bar[XB_XSUB(b.x)], 1u);
        const unsigned gen = old / nloc;
        if (old + 1u == (gen + 1u) * nloc) {
            __builtin_amdgcn_fence(__ATOMIC_RELEASE, "agent");
            asm volatile("s_waitcnt vmcnt(0)" ::: "memory");
            const unsigned og = xb_add(&bar[XB_TOP], 1u);
            const unsigned tg = og / nx;
            if (og + 1u == (tg + 1u) * nx) xb_add(&bar[XB_TOPGEN], 1u);
            else XB_SPIN(xb_ld(&bar[XB_TOPGEN]) == tg, bar);
            __builtin_amdgcn_fence(__ATOMIC_ACQUIRE, "agent");
            xb_add(&bar[XB_XGEN(b.x)], 1u);
            asm volatile("s_waitcnt vmcnt(0)" ::: "memory");
        } else {
            XB_SPIN(xb_ld(&bar[XB_XGEN(b.x)]) == gen, bar);
            __builtin_amdgcn_fence(__ATOMIC_ACQUIRE, "agent");
            asm volatile("s_waitcnt vmcnt(0)" ::: "memory");
        }
    }
    __syncthreads();
}

namespace pg8 {
constexpr int BM = 256, BK = 64, HALF = 128, HTB = HALF * BK * 2, STAGE_BYTES = 8 * HTB, NXCD = 8, WGM = 4;
__host__ __device__ __forceinline__ int lds_byte(int r, int c) { const int st = (r >> 4) * 2 + (c >> 5), rr = r & 15, cc = c & 31, ob = rr * 64 + cc * 2; return st * 1024 + (ob ^ (((ob >> 9) & 1) << 5)); }
__host__ __device__ __forceinline__ void stage_rc(int b, int& R, int& C) { const int st = b / 1024, sb = b % 1024, swz = sb ^ (((sb >> 9) & 1) << 5); R = (st >> 1) * 16 + swz / 64; C = (st & 1) * 32 + (swz % 64) / 2; }
__host__ __device__ __forceinline__ int perm32(int rho) { const int n = rho >> 4, i = rho & 15; return 8 * (i >> 2) + 4 * n + (i & 3); }

struct Unit { int pm, pn, bn; };
struct Gemm { const bf16_t* A; const bf16_t* Bt; int K; int lda; int ldb = 0; };

struct StaticOrder {
    int nM, nN, nwg, G, c;
    __host__ __device__ void init(int nM_, int nN_, int G_, int c_) { nM = nM_; nN = nN_; nwg = nM * nN; G = G_; c = c_; }
    __host__ __device__ bool next(int i, Unit& u) const {
        const long L = (long)i * G + c; if (L >= nwg) return false;
        int wgid = (int)L; { const int q = nwg / NXCD, r = nwg % NXCD, xcd = wgid % NXCD, off = wgid / NXCD; wgid = (xcd < r ? xcd * (q + 1) : r * (q + 1) + (xcd - r) * q) + off; }
        const int nig = WGM * nN, gid = wgid / nig, fm = gid * WGM, gsz = (nM - fm) < WGM ? (nM - fm) : WGM;
        u.pm = fm + ((wgid % nig) % gsz); u.pn = (wgid % nig) / gsz; u.bn = u.pn; return true;
    }
    __device__ __forceinline__ void gather(const Unit&, int, int, unsigned (&)[2][2]) const {}
};

template <class Epi, class Sched, bool GATHER = false, int OPM = 0  , bool ALIGN_EPI = true, bool SP2 = true>
__device__ __forceinline__ void gemm_phase(LAS unsigned char* lds, const Gemm g, const Sched& S, const Epi& E, int tid) {
    const int wid = __builtin_amdgcn_readfirstlane(tid >> 6), lane = tid & 63, wr = wid >> 2, wc = wid & 3, fr = lane & 15, fq = lane >> 4;
    const int K = g.K, nt = K / BK, lda = g.lda, ldb = g.ldb ? g.ldb : g.K;
    unsigned voffA[2], voffB[2]; int stR[2], stC[2];
#pragma unroll
    for (int i = 0; i < 2; ++i) { int R, C; stage_rc(tid * 16 + i * 8192, R, C); const int Rb = Epi::PERM ? ((R & ~31) + perm32(R & 31)) : R;
        stR[i] = R; stC[i] = C; voffA[i] = (unsigned)(R * lda + C) * 2u; voffB[i] = (unsigned)(Rb * ldb + C) * 2u; }
    const size_t kstep = (size_t)(BK * 2);
    const size_t hstepA = GATHER ? 0 : (size_t)HALF * lda * 2, hstepB = (size_t)HALF * ldb * 2;
    const size_t tstepA = (size_t)BM * lda * 2, tstepB = 2 * hstepB;
    const unsigned ldsw = (unsigned)wid * 1024u;
    const int aoff = lds_byte(wr * 64 + fr, fq * 8), boff = lds_byte(wc * 32 + fr, fq * 8);
#define PG8_SA(b, h) (((b) * 2 + (h)) * HTB)
#define PG8_SB(b, h) ((4 + (b) * 2 + (h)) * HTB)
#define PG8_STAGE(bufoff, gbase, voff) do { _Pragma("unroll") for (int _i = 0; _i < 2; ++_i) \
        __builtin_amdgcn_global_load_lds((const unsigned*)((const char*)(gbase) + (voff)[_i]), (LAS unsigned*)(lds + (bufoff) + ldsw + _i * 8192), 16, 0, 0); } while (0)
#define PG8_LDA(dst, b, h) do { _Pragma("unroll") for (int m = 0; m < 4; ++m) _Pragma("unroll") for (int k = 0; k < 2; ++k) dst[m][k] = *(const LAS bf16x8*)(lds + PG8_SA(b, h) + aoff + m * 2048 + k * 1024); } while (0)
#define PG8_LDB(dst, b, h) do { _Pragma("unroll") for (int n = 0; n < 2; ++n) _Pragma("unroll") for (int k = 0; k < 2; ++k) dst[n][k] = *(const LAS bf16x8*)(lds + PG8_SB(b, h) + boff + n * 2048 + k * 1024); } while (0)
#define PG8_MMA(ai, bj, At, Bt) do { __builtin_amdgcn_s_setprio(1); _Pragma("unroll") for (int m = 0; m < 4; ++m) _Pragma("unroll") for (int n = 0; n < 2; ++n) _Pragma("unroll") for (int k = 0; k < 2; ++k) { \
        if constexpr (OPM == 1) acc[ai][bj][m][n] = __builtin_bit_cast(AccT, __builtin_amdgcn_mfma_i32_16x16x64_i8(__builtin_bit_cast(i32x4, Bt[n][k]), __builtin_bit_cast(i32x4, At[m][k]), __builtin_bit_cast(i32x4, acc[ai][bj][m][n]), 0, 0, 0)); \
        else acc[ai][bj][m][n] = __builtin_bit_cast(AccT, __builtin_amdgcn_mfma_f32_16x16x32_bf16(Bt[n][k], At[m][k], __builtin_bit_cast(f32x4, acc[ai][bj][m][n]), 0, 0, 0)); } __builtin_amdgcn_s_setprio(0); } while (0)
#define PG8_WAIT_V(n) asm volatile("s_waitcnt vmcnt(" #n ")" ::: "memory")
#define PG8_WAIT_L(n) asm volatile("s_waitcnt lgkmcnt(" #n ")" ::: "memory")
#define PG8_BAR __builtin_amdgcn_s_barrier()
#define PG8_SCHED __builtin_amdgcn_sched_barrier(0)
    Unit cur, nxt; int ui = 0;
    if (!S.next(0, cur)) return;
    using AccT = typename Epi::AccT;
    AccT acc[2][2][4][2];
#pragma unroll
    for (int a = 0; a < 2; ++a)
#pragma unroll
        for (int b = 0; b < 2; ++b)
#pragma unroll
            for (int m = 0; m < 4; ++m)
#pragma unroll
                for (int n = 0; n < 2; ++n) acc[a][b][m][n] = AccT{};
    bf16x8 At[4][2], B0[2][2], B1[2][2];
    unsigned gC[2][2], gN[2][2];
    const char* cA = GATHER ? (const char*)g.A : (const char*)g.A + (size_t)cur.pm * tstepA; const char* cB = (const char*)g.Bt + (size_t)cur.bn * tstepB;
    if constexpr (GATHER) { S.gather(cur, stR[0], stR[1], gC);
#pragma unroll
        for (int h = 0; h < 2; ++h)
#pragma unroll
            for (int i = 0; i < 2; ++i) { gC[h][i] = gC[h][i] * (unsigned)(lda * 2) + (unsigned)stC[i] * 2u; gN[h][i] = gC[h][i]; } }
#define PG8_STAGE_A(bufoff, p, h, off) do { if constexpr (GATHER) { PG8_STAGE(bufoff, p, (off)[h]); } else { PG8_STAGE(bufoff, (p) + (h) * hstepA, voffA); } } while (0)
    if constexpr (SP2) {
        PG8_STAGE(PG8_SB(0, 0), cB, voffB); PG8_STAGE(PG8_SB(0, 1), cB + hstepB, voffB); PG8_STAGE_A(PG8_SA(0, 0), cA, 0, gC); PG8_STAGE_A(PG8_SA(0, 1), cA, 1, gC);
        if (wr == 1) PG8_BAR;
        PG8_WAIT_V(2); PG8_BAR;
        PG8_STAGE(PG8_SB(1, 0), cB + kstep, voffB); PG8_STAGE_A(PG8_SA(1, 0), cA + kstep, 0, gC); PG8_STAGE(PG8_SB(1, 1), cB + hstepB + kstep, voffB);
        PG8_WAIT_V(6); PG8_BAR;
    } else {
        PG8_STAGE(PG8_SB(0, 0), cB, voffB); PG8_STAGE_A(PG8_SA(0, 0), cA, 0, gC); PG8_STAGE(PG8_SB(0, 1), cB + hstepB, voffB); PG8_STAGE_A(PG8_SA(0, 1), cA, 1, gC);
        if (wr == 1) PG8_BAR;
        PG8_WAIT_V(4); PG8_BAR;
        PG8_STAGE(PG8_SB(1, 0), cB + kstep, voffB); PG8_STAGE_A(PG8_SA(1, 0), cA + kstep, 0, gC); PG8_STAGE(PG8_SB(1, 1), cB + hstepB + kstep, voffB);
        PG8_WAIT_V(6); PG8_BAR;
    }
    for (;;) {
        const bool has_next = S.next(ui + 1, nxt);
        const char* nA = GATHER ? (const char*)g.A : (has_next ? (const char*)g.A + (size_t)nxt.pm * tstepA : cA);
        const char* nB = has_next ? (const char*)g.Bt + (size_t)nxt.bn * tstepB : cB;
        if constexpr (GATHER) {
            if (has_next) { S.gather(nxt, stR[0], stR[1], gN);
#pragma unroll
                for (int h = 0; h < 2; ++h)
#pragma unroll
                    for (int i = 0; i < 2; ++i) gN[h][i] = gN[h][i] * (unsigned)(lda * 2) + (unsigned)stC[i] * 2u; }
            else {
#pragma unroll
                for (int h = 0; h < 2; ++h)
#pragma unroll
                    for (int i = 0; i < 2; ++i) gN[h][i] = gC[h][i]; }
        }
        asm volatile(".p2align 8" ::: "memory");
#pragma nounroll
        for (int t = 0; t < nt; t += 2) {
            const bool last = (t == nt - 2);
            const char* a1 = cA + (size_t)(t + 1) * kstep;
            const char* a2 = last ? nA : cA + (size_t)(t + 2) * kstep; const char* b2 = last ? nB : cB + (size_t)(t + 2) * kstep;
            const char* a3 = a2 + kstep; const char* b3 = b2 + kstep;
            unsigned g2[2][2];
#pragma unroll
            for (int h = 0; h < 2; ++h)
#pragma unroll
                for (int i = 0; i < 2; ++i) g2[h][i] = GATHER ? (last ? gN[h][i] : gC[h][i]) : 0u;
            if constexpr (SP2) {
            PG8_LDB(B0, 0, 0); PG8_LDB(B1, 0, 1); PG8_SCHED; PG8_LDA(At, 0, 0); PG8_STAGE_A(PG8_SA(1, 1), a1, 1, gC);
            PG8_WAIT_V(8); PG8_WAIT_L(0); PG8_BAR;
            if constexpr (Epi::LDS_SCALES) { if (t == 0 && wid == 0) E.prefetch(lds + STAGE_BYTES, cur); }
            PG8_MMA(0, 0, At, B0); PG8_MMA(0, 1, At, B1); PG8_BAR; PG8_SCHED;
            PG8_LDA(At, 0, 1); PG8_STAGE(PG8_SB(0, 0), b2, voffB); PG8_STAGE(PG8_SB(0, 1), b2 + hstepB, voffB); PG8_STAGE_A(PG8_SA(0, 0), a2, 0, g2);
            PG8_WAIT_V(8); PG8_WAIT_L(0); PG8_BAR; PG8_MMA(1, 0, At, B0); PG8_MMA(1, 1, At, B1); PG8_BAR; PG8_SCHED;
            PG8_LDB(B0, 1, 0); PG8_LDB(B1, 1, 1); PG8_SCHED; PG8_LDA(At, 1, 0); PG8_STAGE_A(PG8_SA(0, 1), a2, 1, g2);
            PG8_WAIT_V(8); PG8_WAIT_L(0); PG8_BAR; PG8_MMA(0, 0, At, B0); PG8_MMA(0, 1, At, B1); PG8_BAR; PG8_SCHED;
            PG8_LDA(At, 1, 1); PG8_STAGE(PG8_SB(1, 0), b3, voffB); PG8_STAGE(PG8_SB(1, 1), b3 + hstepB, voffB); PG8_STAGE_A(PG8_SA(1, 0), a3, 0, g2);
            PG8_WAIT_V(8); PG8_WAIT_L(0); PG8_BAR; PG8_MMA(1, 0, At, B0); PG8_MMA(1, 1, At, B1); PG8_BAR; PG8_SCHED;
            } else {
            PG8_LDB(B0, 0, 0); PG8_SCHED; PG8_LDA(At, 0, 0); PG8_STAGE_A(PG8_SA(1, 1), a1, 1, gC);
            PG8_WAIT_L(8); PG8_BAR; PG8_WAIT_L(0); PG8_MMA(0, 0, At, B0); PG8_BAR; PG8_SCHED;
            PG8_LDB(B1, 0, 1); PG8_STAGE(PG8_SB(0, 0), b2, voffB);
            PG8_BAR; PG8_WAIT_L(0); PG8_MMA(0, 1, At, B1); PG8_BAR;
            PG8_LDA(At, 0, 1); PG8_STAGE_A(PG8_SA(0, 0), a2, 0, g2);
            PG8_BAR; PG8_WAIT_L(0); PG8_MMA(1, 0, At, B0); PG8_BAR; PG8_SCHED;
            PG8_STAGE(PG8_SB(0, 1), b2 + hstepB, voffB);
            PG8_WAIT_V(6); PG8_BAR; PG8_MMA(1, 1, At, B1); PG8_BAR;
            PG8_LDB(B0, 1, 0); PG8_SCHED; PG8_LDA(At, 1, 0); PG8_STAGE_A(PG8_SA(0, 1), a2, 1, g2);
            PG8_WAIT_L(8); PG8_BAR; PG8_WAIT_L(0); PG8_MMA(0, 0, At, B0); PG8_BAR; PG8_SCHED;
            PG8_LDB(B1, 1, 1); PG8_STAGE(PG8_SB(1, 0), b3, voffB);
            PG8_BAR; PG8_WAIT_L(0); PG8_MMA(0, 1, At, B1); PG8_BAR;
            PG8_LDA(At, 1, 1); PG8_STAGE_A(PG8_SA(1, 0), a3, 0, g2);
            PG8_BAR; PG8_WAIT_L(0); PG8_MMA(1, 0, At, B0); PG8_BAR; PG8_SCHED;
            PG8_STAGE(PG8_SB(1, 1), b3 + hstepB, voffB);
            PG8_WAIT_V(6); PG8_BAR; PG8_MMA(1, 1, At, B1); PG8_BAR;
            }
        }
        if constexpr (ALIGN_EPI) { if (wr == 0) PG8_BAR; }
        if constexpr (Epi::LDS_SCALES) E(acc, cur, wr, wc, fr, fq, lds + STAGE_BYTES); else E(acc, cur, wr, wc, fr, fq);
#ifdef EPI_TWICE
        if constexpr (Epi::LDS_SCALES) { asm volatile("" ::: "memory"); E(acc, cur, wr, wc, fr, fq, lds + STAGE_BYTES); }
#endif
        if (!has_next) break;
#pragma unroll
        for (int a = 0; a < 2; ++a)
#pragma unroll
            for (int b = 0; b < 2; ++b)
#pragma unroll
                for (int m = 0; m < 4; ++m)
#pragma unroll
                    for (int n = 0; n < 2; ++n) acc[a][b][m][n] = AccT{};
        cur = nxt; cA = nA; cB = nB; ++ui;
        if constexpr (GATHER) {
#pragma unroll
            for (int h = 0; h < 2; ++h)
#pragma unroll
                for (int i = 0; i < 2; ++i) gC[h][i] = gN[h][i]; }
        if constexpr (ALIGN_EPI) { if (wr == 1) PG8_BAR; }
    }
    PG8_WAIT_V(0);
    if constexpr (!ALIGN_EPI) { if (wr == 0) PG8_BAR; }
    PG8_BAR;
#undef PG8_SA
#undef PG8_SB
#undef PG8_STAGE
#undef PG8_STAGE_A
#undef PG8_LDA
#undef PG8_LDB
#undef PG8_MMA
#undef PG8_WAIT_V
#undef PG8_WAIT_L
#undef PG8_BAR
#undef PG8_SCHED
}
}

struct Params { const float* in[N_IN]; float* out; unsigned char* ws; int ph_lo, ph_hi; };

struct Ctx {
    const float* const* in; float* out; unsigned char* ws;
    int tid, lane, wave, G, bid;
    LAS unsigned char* lds;
    __device__ __forceinline__ unsigned* ctl() const { return (unsigned*)(ws + WS_CTL); }
    __device__ __forceinline__ const float* mod(int l) const { return (const float*)(ws + WS_MOD) + (size_t)l * 17 * 6144; }
    __device__ __forceinline__ bf16_t* H() const { return (bf16_t*)(ws + WS_H); }
    __device__ __forceinline__ signed char* H8() const { return (signed char*)(ws + WS_H); }
    __device__ __forceinline__ float* HS() const { return (float*)(ws + WS_HS); }
    __device__ __forceinline__ float* wsc(size_t off) const { return (float*)(ws + WS_WSC + off); }
    __device__ __forceinline__ bf16_t* ZIN() const { return (bf16_t*)(ws + WS_BIG + BG_ZIN); }
    __device__ __forceinline__ bf16_t* Q() const { return (bf16_t*)(ws + WS_BIG + BG_Q); }
    __device__ __forceinline__ bf16_t* KV() const { return (bf16_t*)(ws + WS_BIG + BG_KV); }
    __device__ __forceinline__ bf16_t* MIX() const { return (bf16_t*)(ws + WS_BIG + BG_MIX); }
    __device__ __forceinline__ bf16_t* HMID() const { return (bf16_t*)(ws + WS_BIG + BG_HMID); }
    __device__ __forceinline__ bf16_t* YPAD() const { return (bf16_t*)(ws + WS_BIG + BG_YPAD); }
    __device__ __forceinline__ bf16_t* XB() const { return (bf16_t*)(ws + WS_XB); }
    __device__ __forceinline__ unsigned char* K8() const { return ws + WS_K8; }
    __device__ __forceinline__ unsigned char* R8() const { return ws + WS_R8; }
    __device__ __forceinline__ unsigned char* VT8() const { return ws + WS_VT8; }
    __device__ __forceinline__ float* SSP() const { return (float*)(ws + WS_SSP); }
    __device__ __forceinline__ const float* ROPE() const { return (const float*)(ws + WS_ROPE); }
    __device__ __forceinline__ bf16_t* wsm(int l, size_t off) const { return (bf16_t*)(ws + WS_WSM + (size_t)l * SM_BYTES + off); }
    __device__ __forceinline__ bf16_t* wffn(int i, size_t off) const { return (bf16_t*)(ws + WS_FFN + (size_t)i * FF_BYTES + off); }
    __device__ __forceinline__ bf16_t* wmoe(size_t off) const { return (bf16_t*)(ws + WS_MOE + off); }
};

__device__ __forceinline__ void rope8(f32x4& v0, f32x4& v1, const float* rope, int t, int fq) {
    const int pos = (fq < 2) ? (t >> 6) : (t & 63);
    const f32x4* tb = (const f32x4*)(rope + (size_t)pos * 16 + (fq & 1) * 8);
    const f32x4 c0 = tb[0], c1 = tb[1];
    f32x4 o0, o1;
    o0[0] = v0[0] * c0[0] - v0[1] * c0[1]; o0[1] = v0[0] * c0[1] + v0[1] * c0[0];
    o0[2] = v0[2] * c0[2] - v0[3] * c0[3]; o0[3] = v0[2] * c0[3] + v0[3] * c0[2];
    o1[0] = v1[0] * c1[0] - v1[1] * c1[1]; o1[1] = v1[0] * c1[1] + v1[1] * c1[0];
    o1[2] = v1[2] * c1[2] - v1[3] * c1[3]; o1[3] = v1[2] * c1[3] + v1[3] * c1[2];
    v0 = o0; v1 = o1;
}
constexpr float HID_SCALE = 16.0f;
__device__ __forceinline__ u32x2 pack8_fp8(const f32x4& v0, const f32x4& v1) {
    f32x4 a = v0 * HID_SCALE, b = v1 * HID_SCALE;
#pragma unroll
    for (int j = 0; j < 4; ++j) { a[j] = fminf(fmaxf(a[j], -448.f), 448.f); b[j] = fminf(fmaxf(b[j], -448.f), 448.f); }
    int w0 = __builtin_amdgcn_cvt_pk_fp8_f32(a[0], a[1], 0, false); w0 = __builtin_amdgcn_cvt_pk_fp8_f32(a[2], a[3], w0, true);
    int w1 = __builtin_amdgcn_cvt_pk_fp8_f32(b[0], b[1], 0, false); w1 = __builtin_amdgcn_cvt_pk_fp8_f32(b[2], b[3], w1, true);
    return (u32x2){(unsigned)w0, (unsigned)w1};
}
constexpr float QKSC = 0.3837244402248873f;
__device__ __forceinline__ u32x2 pack8_f8s(const f32x4& v0, const f32x4& v1, float sc) {
    int w0 = __builtin_amdgcn_cvt_pk_fp8_f32(v0[0] * sc, v0[1] * sc, 0, false); w0 = __builtin_amdgcn_cvt_pk_fp8_f32(v0[2] * sc, v0[3] * sc, w0, true);
    int w1 = __builtin_amdgcn_cvt_pk_fp8_f32(v1[0] * sc, v1[1] * sc, 0, false); w1 = __builtin_amdgcn_cvt_pk_fp8_f32(v1[2] * sc, v1[3] * sc, w1, true);
    return (u32x2){(unsigned)w0, (unsigned)w1};
}
__device__ __forceinline__ u32x4 pack8(const f32x4& v0, const f32x4& v1) {
    u32x4 w; w.x = cvt_pk_bf16(v0[0], v0[1]); w.y = cvt_pk_bf16(v0[2], v0[3]); w.z = cvt_pk_bf16(v1[0], v1[1]); w.w = cvt_pk_bf16(v1[2], v1[3]); return w;
}

struct EpiIn {
    static constexpr bool PERM = true, LDS_SCALES = true; using AccT = i32x4;
    bf16_t* Z; float* ssp; const float* rope; const float* hs; const float* wscale; unsigned char* kr8;
    __device__ __forceinline__ void prefetch(LAS unsigned char* scr, const pg8::Unit& u) const {
        const int lane = (int)__builtin_amdgcn_mbcnt_hi(~0u, __builtin_amdgcn_mbcnt_lo(~0u, 0u));
        __builtin_amdgcn_global_load_lds((const unsigned*)(hs + (size_t)u.pm * 256 + 4 * lane), (LAS unsigned*)scr, 16, 0, 0);
        __builtin_amdgcn_global_load_lds((const unsigned*)(wscale + (size_t)u.pn * 256 + 4 * lane), (LAS unsigned*)(scr + 1024), 16, 0, 0);
    }
    __device__ __forceinline__ void operator()(const i32x4 (&acc)[2][2][4][2], const pg8::Unit& u, int wr, int wc, int fr, int fq, const LAS unsigned char* scr) const {
        const int row0 = u.pm * 256 + wr * 64 + fr, pn = u.pn;
        f32x4 cs[2][2];
#pragma unroll
        for (int bj = 0; bj < 2; ++bj) { const LAS float* wp = (const LAS float*)(scr + 1024) + bj * 128 + wc * 32 + 8 * fq; cs[bj][0] = *(const LAS f32x4*)wp; cs[bj][1] = *(const LAS f32x4*)(wp + 4); }
#pragma unroll
        for (int ai = 0; ai < 2; ++ai)
#pragma unroll
            for (int m = 0; m < 4; ++m) {
                const int row = row0 + ai * 128 + m * 16;
                bf16_t* rowp = Z + (size_t)row * ZP + pn * 256 + wc * 32 + 8 * fq; const float rs = ((const LAS float*)scr)[wr * 64 + fr + ai * 128 + m * 16];
                float ss[2];
#pragma unroll
                for (int bj = 0; bj < 2; ++bj) {
                    f32x4 v0 = __builtin_convertvector(acc[ai][bj][m][0], f32x4) * cs[bj][0] * rs, v1 = __builtin_convertvector(acc[ai][bj][m][1], f32x4) * cs[bj][1] * rs;
                    ss[bj] = (v0[0] * v0[0] + v0[1] * v0[1]) + (v0[2] * v0[2] + v0[3] * v0[3]) + (v1[0] * v1[0] + v1[1] * v1[1]) + (v1[2] * v1[2] + v1[3] * v1[3]);
                    if (pn < 3) {
                        const f32x4 z0 = (v0 * -2.302208198144325f) * (1.0f + 0.044715f * (v0 * v0)), z1 = (v1 * -2.302208198144325f) * (1.0f + 0.044715f * (v1 * v1));
                        f32x4 e0, e1;
#pragma unroll
                        for (int j = 0; j < 4; ++j) { e0[j] = fast_exp2(z0[j]); e1[j] = fast_exp2(z1[j]); }
                        const f32x4 d0 = e0 + 1.0f, d1 = e1 + 1.0f;
#pragma unroll
                        for (int j = 0; j < 4; ++j) { e0[j] = fast_rcp(d0[j]); e1[j] = fast_rcp(d1[j]); }
                        v0 = v0 * e0; v1 = v1 * e1;
                    }
                    if (pn == 6 && bj == 1 && wc == 0) { if (row < NLAT) rope8(v0, v1, rope, row & (SEQ - 1), fq);
                        *(u32x2*)(kr8 + (size_t)row * 32 + 8 * fq) = pack8_f8s(v0, v1, QKSC); }
                    if (!(pn == 6 && bj == 1)) *(u32x4*)(rowp + bj * 128) = pack8(v0, v1);
                }
                if (pn >= 4) {
                    float s0 = ss[0], s1 = ss[1];
                    s0 += xor16_f(s0); s0 = sum32_f(s0); s1 += xor16_f(s1); s1 = sum32_f(s1);
                    if (fq == 0) {
                        float* sp = ssp + (size_t)row * 16;
                        if (pn == 4) sp[wc] = s0 + s1;
                        else if (pn == 5) { sp[4 + wc] = s0; sp[8 + wc] = s1; }
                        else sp[12 + wc] = s0;
                    }
                }
            }
    }
};

struct EpiInB {
    static constexpr bool PERM = true, LDS_SCALES = false; using AccT = f32x4;
    bf16_t* Z; float* ssp; const float* rope;
    __device__ __forceinline__ void operator()(const f32x4 (&acc)[2][2][4][2], const pg8::Unit& u, int wr, int wc, int fr, int fq) const {
        const int row0 = u.pm * 256 + wr * 64 + fr, pn = u.pn;
#pragma unroll
        for (int ai = 0; ai < 2; ++ai)
#pragma unroll
            for (int m = 0; m < 4; ++m) {
                const int row = row0 + ai * 128 + m * 16;
                bf16_t* rowp = Z + (size_t)row * ZP + pn * 256 + wc * 32 + 8 * fq;
                float ss[2];
#pragma unroll
                for (int bj = 0; bj < 2; ++bj) {
                    f32x4 v0 = acc[ai][bj][m][0], v1 = acc[ai][bj][m][1];
                    ss[bj] = (v0[0] * v0[0] + v0[1] * v0[1]) + (v0[2] * v0[2] + v0[3] * v0[3]) + (v1[0] * v1[0] + v1[1] * v1[1]) + (v1[2] * v1[2] + v1[3] * v1[3]);
                    if (pn < 3) {
#pragma unroll
                        for (int j = 0; j < 4; ++j) { v0[j] = gelu_tanh_f(v0[j]); v1[j] = gelu_tanh_f(v1[j]); }
                    }
                    if (pn == 6 && bj == 1 && wc == 0 && row < NLAT) rope8(v0, v1, rope, row & (SEQ - 1), fq);
                    *(u32x4*)(rowp + bj * 128) = pack8(v0, v1);
                }
                if (pn >= 4) {
                    float s0 = ss[0], s1 = ss[1];
                    s0 += xor16_f(s0); s0 = sum32_f(s0); s1 += xor16_f(s1); s1 = sum32_f(s1);
                    if (fq == 0) {
                        float* sp = ssp + (size_t)row * 16;
                        if (pn == 4) sp[wc] = s0 + s1;
                        else if (pn == 5) { sp[4 + wc] = s0; sp[8 + wc] = s1; }
                        else sp[12 + wc] = s0;
                    }
                }
            }
    }
};

__device__ __forceinline__ void ssp_prefetch(LAS unsigned char* scr, const float* ssp, int tok0, int slot0) {
    const int lane = (int)__builtin_amdgcn_mbcnt_hi(~0u, __builtin_amdgcn_mbcnt_lo(~0u, 0u));
    const float* gp = ssp + (size_t)(tok0 + (lane >> 1)) * 16 + slot0 + (lane & 1) * 4;
#pragma nounroll
    for (int i = 0; i < 8; ++i)
        __builtin_amdgcn_global_load_lds((const unsigned*)(gp + (size_t)i * 512), (LAS unsigned*)(scr + i * 1024), 16, 0, 0);
}
constexpr float QSCALE = 0.10206207261596577f * 1.4426950408889634f;
struct EpiQ {
    static constexpr bool PERM = true, LDS_SCALES = true; using AccT = f32x4;
    bf16_t* Qo; const float* ssp; const float* rope;
    __device__ __forceinline__ void prefetch(LAS unsigned char* scr, const pg8::Unit& u) const { ssp_prefetch(scr, ssp, u.pm * 256, 0); }
    __device__ __forceinline__ void operator()(const f32x4 (&acc)[2][2][4][2], const pg8::Unit& u, int wr, int wc, int fr, int fq, const LAS unsigned char* scr) const {
        const int row0 = u.pm * 256 + wr * 64 + fr, pn = u.pn;
        float rstd[2][4];
#pragma unroll
        for (int ai = 0; ai < 2; ++ai)
#pragma unroll
            for (int m = 0; m < 4; ++m) {
                const LAS f32x4* sp = (const LAS f32x4*)(scr + (size_t)(wr * 64 + fr + ai * 128 + m * 16) * 32);
                const f32x4 a = sp[0], b = sp[1];
                rstd[ai][m] = __builtin_amdgcn_rsqf(((a[0] + a[1]) + (a[2] + a[3]) + (b[0] + b[1]) + (b[2] + b[3])) * (1.0f / QLORA) + EPS) * QKSC;
            }
#pragma unroll
        for (int ai = 0; ai < 2; ++ai)
#pragma unroll
            for (int m = 0; m < 4; ++m) {
                const int row = row0 + ai * 128 + m * 16;
                unsigned char* rowp = (unsigned char*)Qo + (size_t)row * QP + pn * 256 + wc * 32 + 8 * fq;
#pragma unroll
                for (int bj = 0; bj < 2; ++bj) {
                    f32x4 v0 = acc[ai][bj][m][0] * rstd[ai][m], v1 = acc[ai][bj][m][1] * rstd[ai][m];
                    const int g32 = pn * 8 + bj * 4 + wc;
                    if ((g32 % 3) == 2 && row < NLAT) rope8(v0, v1, rope, row & (SEQ - 1), fq);
                    *(u32x2*)(rowp + bj * 128) = pack8_f8s(v0, v1, 1.0f);
                }
            }
    }
};

struct EpiKV {
    static constexpr bool PERM = true, LDS_SCALES = true; using AccT = f32x4;
    bf16_t* O; const float* ssp; unsigned char* k8;
    __device__ __forceinline__ void prefetch(LAS unsigned char* scr, const pg8::Unit& u) const { ssp_prefetch(scr, ssp, u.pm * 256, 8); }
    __device__ __forceinline__ void operator()(const f32x4 (&acc)[2][2][4][2], const pg8::Unit& u, int wr, int wc, int fr, int fq, const LAS unsigned char* scr) const {
        const int row0 = u.pm * 256 + wr * 64 + fr, pn = u.pn;
        float rstd[2][4];
#pragma unroll
        for (int ai = 0; ai < 2; ++ai)
#pragma unroll
            for (int m = 0; m < 4; ++m) {
                const LAS f32x4* sp = (const LAS f32x4*)(scr + (size_t)(wr * 64 + fr + ai * 128 + m * 16) * 32);
                const f32x4 a = sp[0], b = sp[1];
                rstd[ai][m] = __builtin_amdgcn_rsqf(((a[0] + a[1]) + (a[2] + a[3]) + (b[0] + b[1]) + (b[2] + b[3])) * (1.0f / KVLORA) + EPS);
            }
#pragma unroll
        for (int ai = 0; ai < 2; ++ai)
#pragma unroll
            for (int m = 0; m < 4; ++m) {
                bf16_t* rowp = O + (size_t)(row0 + ai * 128 + m * 16) * KVP + pn * 256 + wc * 32 + 8 * fq;
#pragma unroll
                for (int bj = 0; bj < 2; ++bj) {
                    const f32x4 v0 = acc[ai][bj][m][0] * rstd[ai][m], v1 = acc[ai][bj][m][1] * rstd[ai][m];
                    if (pn < 2) *(u32x2*)(k8 + (size_t)(row0 + ai * 128 + m * 16) * 512 + pn * 256 + bj * 128 + wc * 32 + 8 * fq) = pack8_f8s(v0, v1, QKSC);
                    else *(u32x4*)(rowp + bj * 128) = pack8(v0, v1);
                }
            }
    }
};

struct EpiVT {
    static constexpr bool PERM = true, LDS_SCALES = true; using AccT = f32x4;
    unsigned char* vt8; const float* ssp;
    __device__ __forceinline__ void prefetch(LAS unsigned char* scr, const pg8::Unit& u) const { ssp_prefetch(scr, ssp, u.pn * 256, 8); }
    __device__ __forceinline__ void operator()(const f32x4 (&acc)[2][2][4][2], const pg8::Unit& u, int wr, int wc, int fr, int fq, const LAS unsigned char* scr) const {
        const int dv0 = u.pm * 256 + wr * 64 + fr;
#pragma unroll
        for (int bj = 0; bj < 2; ++bj) {
            const int t0 = u.pn * 256 + bj * 128 + wc * 32 + 8 * fq;
            f32x4 r0, r1;
#pragma unroll
            for (int j = 0; j < 8; ++j) { const LAS f32x4* sp = (const LAS f32x4*)(scr + (size_t)(bj * 128 + wc * 32 + 8 * fq + j) * 32); const f32x4 a = sp[0], b = sp[1];
                const float rs = __builtin_amdgcn_rsqf(((a[0] + a[1]) + (a[2] + a[3]) + (b[0] + b[1]) + (b[2] + b[3])) * (1.0f / KVLORA) + EPS);
                if (j < 4) r0[j & 3] = rs; else r1[j & 3] = rs; }
#pragma unroll
            for (int ai = 0; ai < 2; ++ai)
#pragma unroll
                for (int m = 0; m < 4; ++m)
                    *(u32x2*)(vt8 + ((size_t)(t0 >> 3) * 512 + (dv0 + ai * 128 + m * 16)) * 8) = pack8_f8s(acc[ai][bj][m][0] * r0, acc[ai][bj][m][1] * r1, 1.0f);
        }
    }
};

struct EpiRes {
    static constexpr bool PERM = true, LDS_SCALES = false; using AccT = f32x4;
    const float* lat32; const float* ctx32; bf16_t* xb; const float* gate;
    const float* cscale;
    __device__ __forceinline__ void operator()(const f32x4 (&acc)[2][2][4][2], const pg8::Unit& u, int wr, int wc, int fr, int fq) const {
        const bool isctx = u.pm >= 256;
        const int bsel = isctx ? 16 : (u.pm >> 4);
        const int row0 = u.pm * 256 + wr * 64 + fr, col0 = u.pn * 256 + wc * 32 + 8 * fq;
        const float* gp = gate + (size_t)bsel * 6144 + col0;
        f32x4 gv[2][2];
#pragma unroll
        for (int bj = 0; bj < 2; ++bj)
#pragma unroll
            for (int n = 0; n < 2; ++n) { gv[bj][n] = *(const f32x4*)(gp + bj * 128 + n * 4); if (cscale) gv[bj][n] = gv[bj][n] * *(const f32x4*)(cscale + col0 + bj * 128 + n * 4); }
        const float* s32 = lat32 ? (isctx ? ctx32 + (size_t)(row0 - NLAT) * DM : lat32 + (size_t)row0 * DM) + col0 : nullptr;
#pragma unroll
        for (int ai = 0; ai < 2; ++ai) {
            bf16_t* xp0 = xb + (size_t)row0 * DM + col0 + (size_t)(ai * 128) * DM;
            if (s32) {
                f32x4 sf[4][2][2];
#pragma unroll
                for (int m = 0; m < 4; ++m)
#pragma unroll
                    for (int bj = 0; bj < 2; ++bj) { const float* sp = s32 + (size_t)(ai * 128 + m * 16) * DM + bj * 128; sf[m][bj][0] = *(const f32x4*)sp; sf[m][bj][1] = *(const f32x4*)(sp + 4); }
#pragma unroll
                for (int m = 0; m < 4; ++m)
#pragma unroll
                    for (int bj = 0; bj < 2; ++bj)
                        *(u32x4*)(xp0 + (size_t)(m * 16) * DM + bj * 128) = pack8(sf[m][bj][0] + gv[bj][0] * acc[ai][bj][m][0], sf[m][bj][1] + gv[bj][1] * acc[ai][bj][m][1]);
            } else {
                u32x4 sb[4][2];
#pragma unroll
                for (int m = 0; m < 4; ++m)
#pragma unroll
                    for (int bj = 0; bj < 2; ++bj) sb[m][bj] = *(const u32x4*)(xp0 + (size_t)(m * 16) * DM + bj * 128);
#pragma unroll
                for (int m = 0; m < 4; ++m)
#pragma unroll
                    for (int bj = 0; bj < 2; ++bj) { const u32x4 r = sb[m][bj]; f32x4 s0, s1;
                        s0[0] = __uint_as_float(r[0] << 16); s0[1] = __uint_as_float(r[0] & 0xffff0000u); s0[2] = __uint_as_float(r[1] << 16); s0[3] = __uint_as_float(r[1] & 0xffff0000u);
                        s1[0] = __uint_as_float(r[2] << 16); s1[1] = __uint_as_float(r[2] & 0xffff0000u); s1[2] = __uint_as_float(r[3] << 16); s1[3] = __uint_as_float(r[3] & 0xffff0000u);
                        *(u32x4*)(xp0 + (size_t)(m * 16) * DM + bj * 128) = pack8(s0 + gv[bj][0] * acc[ai][bj][m][0], s1 + gv[bj][1] * acc[ai][bj][m][1]); }
            }
        }
    }
};

struct EpiGlu {
    static constexpr bool PERM = true, LDS_SCALES = true; using AccT = i32x4;
    bf16_t* O; int ld; const float* hs; const float* wscale; const int* list; const float* rscale; const LAS int* tab; int pm0, nN;
    __device__ __forceinline__ void prefetch(LAS unsigned char* scr, const pg8::Unit& u) const {
        const float* rp;
        if (list) { const int e = u.bn / nN, tpe = __builtin_amdgcn_readfirstlane(tab[e]); rp = rscale + (size_t)e * NTOK + (size_t)(pm0 + u.pm - tpe) * 256; }
        else rp = hs + (size_t)u.pm * 256;
        const int lane = (int)__builtin_amdgcn_mbcnt_hi(~0u, __builtin_amdgcn_mbcnt_lo(~0u, 0u));
        __builtin_amdgcn_global_load_lds((const unsigned*)(rp + 4 * lane), (LAS unsigned*)scr, 16, 0, 0);
        __builtin_amdgcn_global_load_lds((const unsigned*)(wscale + (size_t)u.bn * 256 + 4 * lane), (LAS unsigned*)(scr + 1024), 16, 0, 0);
    }
    __device__ __forceinline__ void operator()(const i32x4 (&acc)[2][2][4][2], const pg8::Unit& u, int wr, int wc, int fr, int fq, const LAS unsigned char* scr) const {
        const int row0 = u.pm * 256 + wr * 64 + fr;
        f32x4 cs[2][2];
#pragma unroll
        for (int bj = 0; bj < 2; ++bj) { const LAS float* wp = (const LAS float*)(scr + 1024) + bj * 128 + wc * 32 + 8 * fq; cs[bj][0] = *(const LAS f32x4*)wp; cs[bj][1] = *(const LAS f32x4*)(wp + 4); }
        float rsc[2][4];
#pragma unroll
        for (int ai = 0; ai < 2; ++ai)
#pragma unroll
            for (int m = 0; m < 4; ++m) rsc[ai][m] = ((const LAS float*)scr)[wr * 64 + fr + ai * 128 + m * 16];
#pragma unroll
        for (int ai = 0; ai < 2; ++ai)
#pragma unroll
            for (int m = 0; m < 4; ++m) {
                bf16_t* rowp = O + (size_t)(row0 + ai * 128 + m * 16) * ld + u.pn * 128 + wc * 32 + 8 * fq; const float rs = rsc[ai][m];
                const f32x4 a0 = __builtin_convertvector(acc[ai][0][m][0], f32x4) * cs[0][0] * rs, g0 = __builtin_convertvector(acc[ai][1][m][0], f32x4) * cs[1][0] * rs;
                const f32x4 a1 = __builtin_convertvector(acc[ai][0][m][1], f32x4) * cs[0][1] * rs, g1 = __builtin_convertvector(acc[ai][1][m][1], f32x4) * cs[1][1] * rs;
                const f32x4 z0 = a0 * -1.4426950408889634f, z1 = a1 * -1.4426950408889634f;
                f32x4 e0, e1;
#pragma unroll
                for (int j = 0; j < 4; ++j) { e0[j] = fast_exp2(z0[j]); e1[j] = fast_exp2(z1[j]); }
                const f32x4 d0 = e0 + 1.0f, d1 = e1 + 1.0f;
                f32x4 r0, r1;
#pragma unroll
                for (int j = 0; j < 4; ++j) { r0[j] = fast_rcp(d0[j]); r1[j] = fast_rcp(d1[j]); }
                const f32x4 v0 = (a0 * g0) * r0, v1 = (a1 * g1) * r1;
                if constexpr (DOWN_FP8) {
                    unsigned char* bp = (unsigned char*)O + (size_t)(row0 + ai * 128 + m * 16) * ld + u.pn * 128 + wc * 32 + 8 * fq;
                    *(u32x2*)bp = pack8_fp8(v0, v1);
                } else *(u32x4*)rowp = pack8(v0, v1);
            }
    }
};

struct EpiBf {
    static constexpr bool PERM = true, LDS_SCALES = false; using AccT = f32x4;
    bf16_t* O; int ld; int row_tile0; const float* cscale; int nN;
    __device__ __forceinline__ void operator()(const f32x4 (&acc)[2][2][4][2], const pg8::Unit& u, int wr, int wc, int fr, int fq) const {
        const int row0 = (u.pm + row_tile0) * 256 + wr * 64 + fr;
        f32x4 cs[2][2];
#pragma unroll
        for (int bj = 0; bj < 2; ++bj) { if (cscale) { const float* wp = cscale + (size_t)u.bn * 256 + bj * 128 + wc * 32 + 8 * fq; cs[bj][0] = *(const f32x4*)wp; cs[bj][1] = *(const f32x4*)(wp + 4); } else { cs[bj][0] = (f32x4){1.f, 1.f, 1.f, 1.f}; cs[bj][1] = cs[bj][0]; } }
#pragma unroll
        for (int ai = 0; ai < 2; ++ai)
#pragma unroll
            for (int m = 0; m < 4; ++m) {
                bf16_t* rowp = O + (size_t)(row0 + ai * 128 + m * 16) * ld + u.pn * 256 + wc * 32 + 8 * fq;
#pragma unroll
                for (int bj = 0; bj < 2; ++bj) *(u32x4*)(rowp + bj * 128) = pack8(acc[ai][bj][m][0] * cs[bj][0], acc[ai][bj][m][1] * cs[bj][1]);
            }
    }
};

struct MoeOrder {
    pg8::StaticOrder base; int pm0, nN; const LAS int* tab; const int* list;
    __device__ __forceinline__ int expert_of(int gpm) const { int e = 0;
#pragma unroll
        for (int j = 1; j < NE; ++j) e += (gpm >= tab[j]) ? 1 : 0;
        return __builtin_amdgcn_readfirstlane(e); }
    __device__ __forceinline__ bool next(int i, pg8::Unit& u) const {
        if (!base.next(i, u)) return false;
        u.bn = expert_of(pm0 + u.pm) * nN + u.pn; return true;
    }
    __device__ __forceinline__ void gather(const pg8::Unit& u, int R0, int R1, unsigned (&o)[2][2]) const {
        const int gpm = pm0 + u.pm, e = expert_of(gpm);
        const int tpe = __builtin_amdgcn_readfirstlane(tab[e]), ce = __builtin_amdgcn_readfirstlane(tab[16 + e]);
        const int base_pos = (gpm - tpe) * 256;
#pragma unroll
        for (int h = 0; h < 2; ++h) {
            const int p0 = base_pos + h * 128 + R0, p1 = base_pos + h * 128 + R1;
            o[h][0] = (p0 < ce) ? (unsigned)list[(size_t)e * NTOK + p0] : 0u;
            o[h][1] = (p1 < ce) ? (unsigned)list[(size_t)e * NTOK + p1] : 0u;
        }
    }
};

template <class Map>
__device__ __forceinline__ void cvt_item(const float* W, int N, bf16_t* WT, int K, LAS float* scr, int item, int lane, const Map& map, const float* kscale) {
    const int nblk = N / 32, kb = item / nblk, nb = item % nblk, k0 = 64 * kb, n0 = 32 * nb;
    { const int c4 = (lane & 7) * 4, kr = lane >> 3;
#pragma unroll
      for (int i = 0; i < 8; ++i) { const int kk = kr + 8 * i; f32x4 v = *(const f32x4*)(W + (size_t)(k0 + kk) * N + n0 + c4); if (kscale) v = v * kscale[k0 + kk];
          scr[kk * 33 + c4] = v[0]; scr[kk * 33 + c4 + 1] = v[1]; scr[kk * 33 + c4 + 2] = v[2]; scr[kk * 33 + c4 + 3] = v[3]; } }
    asm volatile("s_waitcnt lgkmcnt(0)" ::: "memory");
    const int c = lane & 7;
#pragma unroll
    for (int j = 0; j < 4; ++j) { const int n = (lane >> 3) + 8 * j; const LAS float* s = scr + (8 * c) * 33 + n;
        u32x4 o; o.x = cvt_pk_bf16(s[0 * 33], s[1 * 33]); o.y = cvt_pk_bf16(s[2 * 33], s[3 * 33]); o.z = cvt_pk_bf16(s[4 * 33], s[5 * 33]); o.w = cvt_pk_bf16(s[6 * 33], s[7 * 33]);
        *(u32x4*)(WT + (size_t)map(n0 + n) * K + k0 + 8 * c) = o; }
    asm volatile("s_waitcnt lgkmcnt(0)" ::: "memory");
}
template <class Map>
__device__ __forceinline__ void cvt8_item(const float* W, int N, int K, signed char* WT, float* scale, LAS float* scr, int item, int lane, const Map& map) {
    const int n0 = 32 * item, c4 = (lane & 7) * 4, kr = lane >> 3;
    f32x4 mx = {0.f, 0.f, 0.f, 0.f};
#pragma unroll 8
    for (int k = kr; k < K; k += 8) { const f32x4 v = *(const f32x4*)(W + (size_t)k * N + n0 + c4);
        mx[0] = fmaxf(mx[0], fabsf(v[0])); mx[1] = fmaxf(mx[1], fabsf(v[1])); mx[2] = fmaxf(mx[2], fabsf(v[2])); mx[3] = fmaxf(mx[3], fabsf(v[3])); }
    LAS float* invs = scr + 64 * 33;
#pragma unroll
    for (int j = 0; j < 4; ++j) { float m = mx[j]; m = fmaxf(m, DPP_F(m, 0x128)); m = fmaxf(m, xor16_f(m)); m = fmaxf(m, xor32_f(m));
        if (lane < 8) { scale[map(n0 + c4 + j)] = m > 0.f ? m * (1.0f / 127.0f) : 1.0f; invs[c4 + j] = m > 0.f ? 127.0f / m : 0.f; } }
    for (int k0 = 0; k0 < K; k0 += 64) {
#pragma unroll
        for (int i = 0; i < 8; ++i) { const int kk = kr + 8 * i; const f32x4 v = *(const f32x4*)(W + (size_t)(k0 + kk) * N + n0 + c4);
            scr[kk * 33 + c4] = v[0]; scr[kk * 33 + c4 + 1] = v[1]; scr[kk * 33 + c4 + 2] = v[2]; scr[kk * 33 + c4 + 3] = v[3]; }
        asm volatile("s_waitcnt lgkmcnt(0)" ::: "memory");
        const int cq = lane & 3;
#pragma unroll
        for (int j = 0; j < 2; ++j) { const int n = (lane >> 2) + 16 * j; const float iv = invs[n]; const LAS float* s = scr + (16 * cq) * 33 + n;
            u32x4 o;
#pragma unroll
            for (int w = 0; w < 4; ++w) { unsigned pk = 0;
#pragma unroll
                for (int b = 0; b < 4; ++b) { const int q = (int)__builtin_rintf(s[(4 * w + b) * 33] * iv); pk |= ((unsigned)q & 0xffu) << (8 * b); }
                o[w] = pk; }
            *(u32x4*)(WT + (size_t)map(n0 + n) * K + k0 + 16 * cq) = o; }
        asm volatile("s_waitcnt lgkmcnt(0)" ::: "memory");
    }
}
template <class Map>
__device__ __forceinline__ void cvtf8_item(const float* W, int N, int K, unsigned char* WT, float* scale, float oscale, LAS float* scr, int item, int lane, const Map& map) {
    const int n0 = 32 * item, c = lane & 31, kh = lane >> 5;
    float mx = 0.f;
    for (int k = kh; k < K; k += 2) mx = fmaxf(mx, fabsf(W[(size_t)k * N + n0 + c]));
    mx = fmaxf(mx, xor32_f(mx));
    const float sc = mx > 0.f ? mx / (448.0f * oscale) : 1.0f, inv = mx > 0.f ? 448.0f / mx : 0.f;
    LAS float* invs = scr + 64 * 33;
    if (lane < 32) { scale[map(n0 + c)] = sc; invs[c] = inv; }
    for (int k0 = 0; k0 < K; k0 += 64) {
#pragma unroll 8
        for (int i = 0; i < 32; ++i) { const int kk = 2 * i + kh; scr[kk * 33 + c] = W[(size_t)(k0 + kk) * N + n0 + c]; }
        asm volatile("s_waitcnt lgkmcnt(0)" ::: "memory");
        const int cq = lane & 3;
#pragma unroll
        for (int j = 0; j < 2; ++j) { const int n = (lane >> 2) + 16 * j; const float iv = invs[n]; const LAS float* s = scr + (16 * cq) * 33 + n;
            u32x4 o;
#pragma unroll
            for (int w = 0; w < 4; ++w) { int pk = __builtin_amdgcn_cvt_pk_fp8_f32(s[(4 * w) * 33] * iv, s[(4 * w + 1) * 33] * iv, 0, false); pk = __builtin_amdgcn_cvt_pk_fp8_f32(s[(4 * w + 2) * 33] * iv, s[(4 * w + 3) * 33] * iv, pk, true); o[w] = (unsigned)pk; }
            *(u32x4*)(WT + (size_t)map(n0 + n) * K + k0 + 16 * cq) = o; }
        asm volatile("s_waitcnt lgkmcnt(0)" ::: "memory");
    }
}
struct MapId { __device__ __forceinline__ int operator()(int c) const { return c; } };
struct MapOff { int off; __device__ __forceinline__ int operator()(int c) const { return c + off; } };
__device__ __forceinline__ int rope_perm(int p) { const int half = p >> 4, w = p & 15, s = w >> 3, i = w & 7; return half * 16 + 2 * i + s; }
struct MapIn { __device__ __forceinline__ int operator()(int c) const { return c < ZR ? c : ZR + rope_perm(c - ZR); } };
struct MapQ { __device__ __forceinline__ int operator()(int c) const { const int h = c / DQK, e = c % DQK; return e < 64 ? c : h * DQK + 64 + rope_perm(e - 64); } };
struct MapGlu { int second; __device__ __forceinline__ int operator()(int c) const { return (c >> 7) * 256 + second * 128 + (c & 127); } };

struct C8Desc { const float* src; signed char* dst; float* scale; int N, n0, kind, sec; };
__device__ __forceinline__ int c8_map(int kind, int sec, int c) { return kind ? (c < ZR ? c : ZR + rope_perm(c - ZR)) : ((c >> 7) * 256 + sec * 128 + (c & 127)); }
__device__ __forceinline__ int c8_count(int set) { return set ? NE * 2 * (DFE / 32) : DEPTH * (D_IN / 32) + 2 * 2 * (DFF / 32) + NE * 2 * (DFE / 32); }
__device__ __forceinline__ C8Desc c8_decode(const Ctx& F, int set, int it) {
    constexpr int I8IN = D_IN / 32, I8F = DFF / 32, I13 = DFE / 32;
    C8Desc d; d.kind = 0;
    if (set == 0 && it < DEPTH * I8IN) { const int l = it / I8IN, item = it % I8IN;
        d.src = F.in[I_WIN] + (size_t)l * DM * D_IN; d.N = D_IN; d.n0 = 32 * item; d.dst = (signed char*)F.wsm(l, SM_IN); d.scale = F.wsc(WSC_IN) + (size_t)l * ZP; d.kind = 1; d.sec = 0; return d; }
    if (set == 0) it -= DEPTH * I8IN;
    if (set == 0 && it < 2 * 2 * I8F) { const int i = it / (2 * I8F), sec = (it / I8F) & 1, item = it % I8F;
        d.src = (sec ? F.in[I_F3] : F.in[I_F1]) + (size_t)i * DM * DFF; d.N = DFF; d.n0 = 32 * item; d.dst = (signed char*)F.wffn(i, FF_13); d.scale = F.wsc(WSC_FF) + (size_t)i * 2 * DFF; d.sec = sec; return d; }
    if (set == 0) it -= 2 * 2 * I8F;
    { const int mi = set, e = it / (2 * I13), r = it % (2 * I13), sec = r / I13, item = r % I13; const size_t eo = ((size_t)mi * NE + e) * (size_t)DM * DFE;
      d.src = (sec ? F.in[I_M3] : F.in[I_M1]) + eo; d.N = DFE; d.n0 = 32 * item; d.dst = (signed char*)F.wmoe(MO_13) + (size_t)e * 2 * DFE * DM; d.scale = F.wsc(WSC_MO) + (size_t)e * 2 * DFE; d.sec = sec; return d; }
}
__device__ __forceinline__ void c8_load(f32x4 (&v)[16], const C8Desc& d, int tid) {
    const float* s = d.src + (size_t)(16 * (tid >> 3)) * d.N + d.n0 + 4 * (tid & 7);
#pragma unroll
    for (int i = 0; i < 16; ++i) v[i] = *(const f32x4*)(s + (size_t)i * d.N);
}
__device__ __forceinline__ void c8_process(const f32x4 (&v)[16], const C8Desc& d, LAS float* red, int tid, int wave) {
    const int c4 = 4 * (tid & 7), kb = tid >> 3;
    f32x4 mx = {0.f, 0.f, 0.f, 0.f};
#pragma unroll
    for (int i = 0; i < 16; ++i) { mx[0] = fmaxf(mx[0], fabsf(v[i][0])); mx[1] = fmaxf(mx[1], fabsf(v[i][1])); mx[2] = fmaxf(mx[2], fabsf(v[i][2])); mx[3] = fmaxf(mx[3], fabsf(v[i][3])); }
#pragma unroll
    for (int j = 0; j < 4; ++j) { float m = mx[j]; m = fmaxf(m, DPP_F(m, 0x128)); m = fmaxf(m, xor16_f(m)); m = fmaxf(m, xor32_f(m)); mx[j] = m; }
    if ((tid & 63) < 8) *(LAS f32x4*)(red + wave * 32 + c4) = mx;
    __syncthreads();
    f32x4 cm = *(const LAS f32x4*)(red + c4);
#pragma unroll
    for (int w = 1; w < NWAVES; ++w) { const f32x4 o = *(const LAS f32x4*)(red + w * 32 + c4); cm[0] = fmaxf(cm[0], o[0]); cm[1] = fmaxf(cm[1], o[1]); cm[2] = fmaxf(cm[2], o[2]); cm[3] = fmaxf(cm[3], o[3]); }
#pragma unroll
    for (int j = 0; j < 4; ++j) {
        const float m = cm[j], inv = m > 0.f ? 127.0f / m : 0.f; const int orow = c8_map(d.kind, d.sec, d.n0 + c4 + j);
        if (tid < 8) d.scale[orow] = m > 0.f ? m * (1.0f / 127.0f) : 1.0f;
        u32x4 o;
#pragma unroll
        for (int w = 0; w < 4; ++w) { unsigned pk = 0;
#pragma unroll
            for (int b = 0; b < 4; ++b) (void)0;
            { const unsigned f0 = __float_as_uint(__builtin_fmaf(v[4 * w][j], inv, 12582912.0f)), f1 = __float_as_uint(__builtin_fmaf(v[4 * w + 1][j], inv, 12582912.0f));
              const unsigned f2 = __float_as_uint(__builtin_fmaf(v[4 * w + 2][j], inv, 12582912.0f)), f3 = __float_as_uint(__builtin_fmaf(v[4 * w + 3][j], inv, 12582912.0f));
              pk = __builtin_amdgcn_perm(f1, f0, 0x0c0c0400u) | __builtin_amdgcn_perm(f3, f2, 0x04000c0cu); }
            o[w] = pk; }
        *(u32x4*)(d.dst + (size_t)orow * DM + 16 * kb) = o;
    }
}
__device__ __forceinline__ void cvt8_run(const Ctx& F, int set, LAS float* red) {
    const int T = c8_count(set);
    int it = F.bid;
    f32x4 va[16], vb[16];
    if (it < T) c8_load(va, c8_decode(F, set, it), F.tid);
#pragma nounroll
    while (it < T) {
        if (it + F.G < T) c8_load(vb, c8_decode(F, set, it + F.G), F.tid);
        c8_process(va, c8_decode(F, set, it), red, F.tid, F.wave);
        it += F.G; if (it >= T) break;
        if (it + F.G < T) c8_load(va, c8_decode(F, set, it + F.G), F.tid);
        c8_process(vb, c8_decode(F, set, it), red + 256, F.tid, F.wave);
        it += F.G;
    }
    __syncthreads();
}

__device__ __forceinline__ void cvt_moe_weights(const Ctx& F, int mi, LAS float* scr) {
    const int gw = F.bid * NWAVES + F.wave, NGW = F.G * NWAVES;
    constexpr int I13 = DFE / 32, I2 = (DFE / 64) * (DM / 32);
    if (DOWN_FP8) {
        for (int it = gw; it < NE * (DM / 32); it += NGW) { const int e = it / (DM / 32), item = it % (DM / 32); const size_t eo = ((size_t)mi * NE + e) * (size_t)DM * DFE;
            cvtf8_item(F.in[I_M2] + eo, DM, DFE, (unsigned char*)F.wmoe(MO_2) + (size_t)e * DM * DFE, F.wsc(WSC_M2) + (size_t)e * DM, HID_SCALE, scr, item, F.lane, MapId{}); }
    } else
    for (int it = gw; it < NE * I2; it += NGW) {
        const int e = it / I2, r = it % I2; const size_t eo = ((size_t)mi * NE + e) * (size_t)DM * DFE;
        cvt_item(F.in[I_M2] + eo, DM, F.wmoe(MO_2) + (size_t)e * DM * DFE, DFE, scr, r, F.lane, MapId{}, nullptr);
    }
}

__device__ __forceinline__ void phase_prologue(const Ctx& F) {
    LAS float* scr = (LAS float*)(F.lds + F.wave * 16384);
    const int gw = F.bid * NWAVES + F.wave, NGW = F.G * NWAVES, gt = F.bid * NTHR + F.tid, NGT = F.G * NTHR;
    for (int i = gt; i < 64 * 8; i += NGT) { const int pos = i >> 3, f = i & 7; const float inv = powf(10000.0f, -(float)(2 * f) / 16.0f); const float a = (float)pos * inv;
        float* r = (float*)(F.ws + WS_ROPE) + i * 2; r[0] = cosf(a); r[1] = sinf(a); }
    for (int i = gt; i < DEPTH * 2 * 256; i += NGT) { const float lam = F.in[I_LAM][i]; const float sp = (lam > 0.f) ? log1pf(expf(-lam)) : (-lam + log1pf(expf(lam)));
        ((float*)(F.ws + WS_C8))[i] = -8.0f * sp; }
    { constexpr int EB = W_IN_I8 ? 1 : 2;
      for (int i = gt; i < DEPTH * (ZP - D_IN) * DM * EB / 16; i += NGT) { const int l = i / ((ZP - D_IN) * DM * EB / 16), r = i % ((ZP - D_IN) * DM * EB / 16);
        *(u32x4*)((signed char*)F.wsm(l, SM_IN) + (size_t)D_IN * DM * EB + (size_t)r * 16) = (u32x4){0u, 0u, 0u, 0u}; } }
    for (int i = gt; i < DEPTH * (ZP - D_IN); i += NGT) F.wsc(WSC_IN)[(size_t)(i / (ZP - D_IN)) * ZP + D_IN + i % (ZP - D_IN)] = 1.0f;
    for (int i = gt; i < DEPTH * 4 * 128 * 128 / 8; i += NGT) { const int l = i / (4 * 128 * 128 / 8), r = i % (4 * 128 * 128 / 8);
        const f32x4* s = (const f32x4*)(F.in[I_SGUW] + (size_t)l * 4 * 128 * 128 + (size_t)r * 8); *(u32x4*)(F.wsm(l, SM_SGU) + (size_t)r * 8) = pack8(s[0], s[1]); }
    {
        LAS float* cs = (LAS float*)(F.lds + 73728);
        for (int i = F.tid; i < 17 * DM; i += NTHR) { const int b = i >> 10, k = i & 1023; const float c = (b < 16) ? F.in[I_C][b * DM + k] : F.in[I_CCTX][k]; cs[i] = silu_f(c); }
        __syncthreads();
        LAS float* red = (LAS float*)(F.lds);
        for (int unit = F.bid; unit < DEPTH * 48; unit += F.G) {
            const int l = unit / 48, n0 = (unit % 48) * 128;
            const float* W = F.in[I_WMOD] + (size_t)l * DM * 6144 + n0 + 2 * F.lane;
            f32x2 a[17];
#pragma unroll
            for (int b = 0; b < 17; ++b) a[b] = (f32x2){0.f, 0.f};
            const int kbeg = F.wave * 128;
#pragma nounroll
            for (int k0 = kbeg; k0 < kbeg + 128; k0 += 16) {
                f32x2 w[16];
#pragma unroll
                for (int i = 0; i < 16; ++i) w[i] = *(const f32x2*)(W + (size_t)(k0 + i) * 6144);
#pragma unroll
                for (int b = 0; b < 17; ++b) {
                    const LAS f32x4* cp = (const LAS f32x4*)(cs + b * DM + k0);
#pragma unroll
                    for (int q = 0; q < 4; ++q) { const f32x4 c = cp[q];
                        a[b] += w[4 * q] * c[0]; a[b] += w[4 * q + 1] * c[1]; a[b] += w[4 * q + 2] * c[2]; a[b] += w[4 * q + 3] * c[3]; }
                }
            }
            __syncthreads();
#pragma unroll
            for (int b = 0; b < 17; ++b) *(LAS f32x2*)(red + (F.wave * 17 + b) * 128 + 2 * F.lane) = a[b];
            __syncthreads();
            for (int i = F.tid; i < 17 * 128; i += NTHR) { const int b = i >> 7, n = i & 127; float s = 0.f;
#pragma unroll
                for (int w = 0; w < 8; ++w) s += red[(w * 17 + b) * 128 + n];
                ((float*)(F.ws + WS_MOD))[((size_t)l * 17 + b) * 6144 + n0 + n] = s + F.in[I_BMOD][l * 6144 + n0 + n]; }
        }
        __syncthreads();
    }
    {
        constexpr int I_IN_ = (DM / 64) * (D_IN / 32), I_OUT_ = (DM / 64) * (DM / 32), I_UQ_ = (QLORA / 64) * (QP / 32), I_UK_ = (KVLORA / 64) * (512 / 32), I_G_ = 2;
        constexpr int PER_L = I_OUT_ + I_UQ_ + 2 * I_UK_ + 16 * I_G_;
        for (int it = gw; it < DEPTH * PER_L; it += NGW) {
            const int l = it / PER_L; int r = it % PER_L;
            if (r < I_OUT_) { cvt_item(F.in[I_WOUT] + (size_t)l * DM * DM, DM, F.wsm(l, SM_OUT), DM, scr, r, F.lane, MapId{}, nullptr); continue; } r -= I_OUT_;
            if (r < I_UQ_) { cvt_item(F.in[I_WUQ] + (size_t)l * QLORA * QP, QP, F.wsm(l, SM_Q), QLORA, scr, r, F.lane, MapQ{}, F.in[I_QN] + l * QLORA); continue; } r -= I_UQ_;
            if (r < I_UK_) { cvt_item(F.in[I_WUK] + (size_t)l * KVLORA * 512, 512, F.wsm(l, SM_KV), KVLORA, scr, r, F.lane, MapId{}, F.in[I_KVN] + l * KVLORA); continue; } r -= I_UK_;
            if (r < I_UK_) { cvt_item(F.in[I_WUV] + (size_t)l * KVLORA * 512, 512, F.wsm(l, SM_KV), KVLORA, scr, r, F.lane, MapOff{512}, F.in[I_KVN] + l * KVLORA); continue; } r -= I_UK_;
            {
                const int mat = r / I_G_, item = r % I_G_, d = mat >> 3, gate = (mat >> 2) & 1, hh = mat & 3;
                const float* src = (gate ? F.in[I_LWX] : F.in[I_LWA]) + (((size_t)l * 2 + d) * 4 + hh) * 64 * 64;
                cvt_item(src, 64, F.wsm(l, SM_GW) + (size_t)((d * 2 + gate) * 4 + hh) * 64 * 64, 64, scr, item, F.lane, MapId{}, nullptr);
            }
        }
        if (!W_IN_I8) { constexpr int I_INB = (DM / 64) * (D_IN / 32);
            for (int it = gw; it < DEPTH * I_INB; it += NGW) { const int l = it / I_INB, r = it % I_INB; cvt_item(F.in[I_WIN] + (size_t)l * DM * D_IN, D_IN, F.wsm(l, SM_IN), DM, scr, r, F.lane, MapIn{}, nullptr); } }
        constexpr int IF2 = (DFF / 64) * (DM / 32);
        if (DOWN_FP8) { for (int it = gw; it < 2 * (DM / 32); it += NGW) { const int i = it / (DM / 32), item = it % (DM / 32);
                cvtf8_item(F.in[I_F2] + (size_t)i * DFF * DM, DM, DFF, (unsigned char*)F.wffn(i, FF_2), F.wsc(WSC_F2) + (size_t)i * DM, HID_SCALE, scr, item, F.lane, MapId{}); } }
        else
        for (int it = gw; it < 2 * IF2; it += NGW) { const int i = it / IF2, r = it % IF2; cvt_item(F.in[I_F2] + (size_t)i * DFF * DM, DM, F.wffn(i, FF_2), DFF, scr, r, F.lane, MapId{}, nullptr); }
        cvt_moe_weights(F, 0, scr);
        cvt8_run(F, 0, (LAS float*)(F.lds + 135168));
    }
}

__device__ __forceinline__ void moe_table(const Ctx& F, int mi, LAS int* tab) {
    if (F.tid < 64) {
        const unsigned* c = F.ctl() + CW_CNT + mi * NE * 64;
        const int n = (F.tid < NE) ? (int)__hip_atomic_load(c + F.tid * 64, __ATOMIC_RELAXED, __HIP_MEMORY_SCOPE_AGENT) : 0;
        const int t = (n + 255) >> 8;
        int inc = t;
        inc += __builtin_amdgcn_update_dpp(0, inc, 0x111, 0xf, 0xf, true);
        inc += __builtin_amdgcn_update_dpp(0, inc, 0x112, 0xf, 0xf, true);
        inc += __builtin_amdgcn_update_dpp(0, inc, 0x114, 0xf, 0xf, true);
        if (F.tid < NE) { tab[16 + F.tid] = n; tab[F.tid] = inc - t; if (F.tid == NE - 1) tab[NE] = inc; }
    }
    __syncthreads();
}

template <int MODE, bool X32 = false>
__device__ __forceinline__ void phase_norm(const Ctx& F, int l, int nrows, bool combine, int mi_prev) {
    const float* modl = F.mod(l < DEPTH ? l : DEPTH - 1);
    const float* gain = (MODE == 0) ? F.in[I_N1G] + l * DM : (MODE == 3) ? F.in[I_FNG] : F.in[I_N2G] + l * DM;
    const int sh_off = (MODE == 0) ? 0 : 3072, sc_off = (MODE == 0) ? 1024 : 4096;
    LAS int* tab = (LAS int*)(F.lds + 65536);
    if (combine) moe_table(F, mi_prev, tab);
    const float* g2prev = F.mod(MODE == 3 ? DEPTH - 1 : l - 1) + 5120;
    LAS float* wr_t = (LAS float*)F.lds;
    LAS int* lcnt = (LAS int*)(F.lds + 32768);
    LAS int* lrow = (LAS int*)(F.lds + 32768 + 256);
    if (MODE == 2) {
        const float* wr = F.in[I_ROUT] + (size_t)(l >> 1) * DM * NE;
        (void)wr_t; (void)wr;
        if (F.tid < 16) lcnt[F.tid] = 0;
        __syncthreads();
    }
    const int gw = F.bid * NWAVES + F.wave, NGW = F.G * NWAVES;
    const float* xlat = F.in[I_X]; const float* xctx = F.in[I_CTX];
    bf16_t* xb = F.XB();
    int lr = F.wave;
    const bool bmap = (NGW == 2048) && (nrows == NLAT || nrows == NTOK);
    const int steps = bmap ? nrows / 2048 : (nrows - gw + NGW - 1) / NGW;
#define ROWOF(k) (bmap ? ((k) < 32 ? (gw >> 7) * 4096 + (gw & 127) + 128 * (k) : NLAT + gw + 2048 * ((k) - 32)) : gw + (k) * NGW)
    f32x4 g1[4], shv[4]; int cbs = -1;
    f32x4 vnx[4]; u32x2 rnx[4];
    if (0 < steps) { const int r0 = ROWOF(0);
        if constexpr (X32) { const float* xr0 = (r0 >= NLAT) ? xctx + (size_t)(r0 - NLAT) * DM : xlat + (size_t)r0 * DM;
#pragma unroll
            for (int j = 0; j < 4; ++j) vnx[j] = *(const f32x4*)(xr0 + 4 * F.lane + 256 * j); }
        else {
#pragma unroll
            for (int j = 0; j < 4; ++j) rnx[j] = *(const u32x2*)(xb + (size_t)r0 * DM + 4 * F.lane + 256 * j); } }
    float wq[NE][16];
    if (MODE == 2) { const float* wr = F.in[I_ROUT] + (size_t)(l >> 1) * DM * NE;
#pragma unroll
        for (int j = 0; j < 4; ++j)
#pragma unroll
            for (int b = 0; b < 4; ++b) { const int c = 4 * F.lane + 256 * j + b; const f32x4 lo = *(const f32x4*)(wr + (size_t)c * NE), hi4 = *(const f32x4*)(wr + (size_t)c * NE + 4);
                wq[0][4 * j + b] = lo[0]; wq[1][4 * j + b] = lo[1]; wq[2][4 * j + b] = lo[2]; wq[3][4 * j + b] = lo[3];
                wq[4][4 * j + b] = hi4[0]; wq[5][4 * j + b] = hi4[1]; wq[6][4 * j + b] = hi4[2]; wq[7][4 * j + b] = hi4[3]; } }
    u32x2 cya[4], cyb[4]; int4 epn = make_int4(0, 0, 0, 0); f32x2 ggc = {0.f, 0.f}, ggn = {0.f, 0.f};
#define YLOAD(ep_) do { const bf16_t* y0_ = F.YPAD() + ((size_t)tab[(ep_).x] * 256 + (ep_).y) * DM, * y1_ = F.YPAD() + ((size_t)tab[(ep_).z] * 256 + (ep_).w) * DM; \
        _Pragma("unroll") for (int j = 0; j < 4; ++j) { cya[j] = *(const u32x2*)(y0_ + 4 * F.lane + 256 * j); cyb[j] = *(const u32x2*)(y1_ + 4 * F.lane + 256 * j); } } while (0)
    if (combine && 0 < steps) { const int r0 = ROWOF(0); const int4 ep0 = *(const int4*)(F.ws + WS_TOPE + (size_t)r0 * 16); ggc = *(const f32x2*)(F.ws + WS_TOPG + (size_t)r0 * 8);
        if (1 < steps) { const int r1 = ROWOF(1); epn = *(const int4*)(F.ws + WS_TOPE + (size_t)r1 * 16); ggn = *(const f32x2*)(F.ws + WS_TOPG + (size_t)r1 * 8); }
        YLOAD(ep0); }
    for (int k = 0; k < steps; ++k, lr += NWAVES) {
        const int row = ROWOF(k);
        const bool isctx = row >= NLAT; const int bsel = isctx ? 16 : (row >> 12);
        f32x4 v[4];
        if constexpr (X32) {
#pragma unroll
            for (int j = 0; j < 4; ++j) v[j] = vnx[j];
            if (k + 1 < steps) { const int rn = ROWOF(k + 1); const float* xrn = (rn >= NLAT) ? xctx + (size_t)(rn - NLAT) * DM : xlat + (size_t)rn * DM;
#pragma unroll
                for (int j = 0; j < 4; ++j) vnx[j] = *(const f32x4*)(xrn + 4 * F.lane + 256 * j); }
        } else {
#pragma unroll
            for (int j = 0; j < 4; ++j) { v[j][0] = __uint_as_float(rnx[j][0] << 16); v[j][1] = __uint_as_float(rnx[j][0] & 0xffff0000u); v[j][2] = __uint_as_float(rnx[j][1] << 16); v[j][3] = __uint_as_float(rnx[j][1] & 0xffff0000u); }
            if (k + 1 < steps) { const int rn = ROWOF(k + 1);
#pragma unroll
                for (int j = 0; j < 4; ++j) rnx[j] = *(const u32x2*)(xb + (size_t)rn * DM + 4 * F.lane + 256 * j); }
        }
        if (bsel != cbs) { cbs = bsel;
#pragma unroll
            for (int j = 0; j < 4; ++j) { const int c = 4 * F.lane + 256 * j; const f32x4 g = *(const f32x4*)(gain + c);
                if (MODE == 3) { g1[j] = g; shv[j] = (f32x4){0.f, 0.f, 0.f, 0.f}; }
                else { const f32x4 sc = *(const f32x4*)(modl + (size_t)bsel * 6144 + sc_off + c); g1[j] = g * (1.0f + sc); shv[j] = *(const f32x4*)(modl + (size_t)bsel * 6144 + sh_off + c); } } }
        if (combine) {
            const f32x2 gg = ggc;
#pragma unroll
            for (int j = 0; j < 4; ++j) {
                const u32x2 a = cya[j], b = cyb[j];
                const f32x4 g = *(const f32x4*)(g2prev + (size_t)bsel * 6144 + 4 * F.lane + 256 * j);
                f32x4 ya, yb; ya[0] = __uint_as_float(a.x << 16); ya[1] = __uint_as_float(a.x & 0xffff0000u); ya[2] = __uint_as_float(a.y << 16); ya[3] = __uint_as_float(a.y & 0xffff0000u);
                yb[0] = __uint_as_float(b.x << 16); yb[1] = __uint_as_float(b.x & 0xffff0000u); yb[2] = __uint_as_float(b.y << 16); yb[3] = __uint_as_float(b.y & 0xffff0000u);
                v[j] = v[j] + g * (ya * gg[0] + yb * gg[1]);
            }
            if (k + 1 < steps) { YLOAD(epn); ggc = ggn;
                if (k + 2 < steps) { const int r2 = ROWOF(k + 2); epn = *(const int4*)(F.ws + WS_TOPE + (size_t)r2 * 16); ggn = *(const f32x2*)(F.ws + WS_TOPG + (size_t)r2 * 8); } }
            if (MODE != 3) {
#pragma unroll
                for (int j = 0; j < 4; ++j) { u32x2 w; w[0] = cvt_pk_bf16(v[j][0], v[j][1]); w[1] = cvt_pk_bf16(v[j][2], v[j][3]); *(u32x2*)(xb + (size_t)row * DM + 4 * F.lane + 256 * j) = w; } }
        }
        float s = 0.f;
#pragma unroll
        for (int j = 0; j < 4; ++j) s += (v[j][0] * v[j][0] + v[j][1] * v[j][1]) + (v[j][2] * v[j][2] + v[j][3] * v[j][3]);
        const float rstd = 1.0f / sqrtf(wave_sum(s) * (1.0f / DM) + EPS);
        if (MODE == 3) {
#pragma unroll
            for (int j = 0; j < 4; ++j) *(f32x4*)(F.out + (size_t)row * DM + 4 * F.lane + 256 * j) = v[j] * rstd * g1[j];
            continue;
        }
        f32x4 h[4]; float amax = 0.f;
#pragma unroll
        for (int j = 0; j < 4; ++j) {
            h[j] = (v[j] * rstd) * g1[j] + shv[j];
            amax = fmaxf(fmaxf(amax, fmaxf(fabsf(h[j][0]), fabsf(h[j][1]))), fmaxf(fabsf(h[j][2]), fabsf(h[j][3])));
        }
        if (MODE == 0 && !W_IN_I8) {
#pragma unroll
            for (int j = 0; j < 4; ++j) { u32x2 w; w.x = cvt_pk_bf16(h[j][0], h[j][1]); w.y = cvt_pk_bf16(h[j][2], h[j][3]); *(u32x2*)(F.H() + (size_t)row * DM + 4 * F.lane + 256 * j) = w; }
            continue;
        }
        amax = wave_max(amax);
        const float qinv = amax > 0.f ? 127.0f / amax : 0.f;
        if (F.lane == 0) F.HS()[row] = amax > 0.f ? amax * (1.0f / 127.0f) : 1.0f;
#pragma unroll
        for (int j = 0; j < 4; ++j) {
            unsigned pk = 0;
#pragma unroll
            for (int b = 0; b < 4; ++b) (void)0;
            {
                const unsigned f0 = __float_as_uint(__builtin_fmaf(h[j][0], qinv, 12582912.0f)), f1 = __float_as_uint(__builtin_fmaf(h[j][1], qinv, 12582912.0f));
                const unsigned f2 = __float_as_uint(__builtin_fmaf(h[j][2], qinv, 12582912.0f)), f3 = __float_as_uint(__builtin_fmaf(h[j][3], qinv, 12582912.0f));
                pk = __builtin_amdgcn_perm(f1, f0, 0x0c0c0400u) | __builtin_amdgcn_perm(f3, f2, 0x04000c0cu); }
            *(unsigned*)(F.H8() + (size_t)row * DM + 4 * F.lane + 256 * j) = pk;
        }
        if (MODE == 2) {
            float lg[NE];
#pragma unroll
            for (int e = 0; e < NE; ++e) { float a = 0.f;
#pragma unroll
                for (int j = 0; j < 4; ++j) a += (h[j][0] * wq[e][4 * j] + h[j][1] * wq[e][4 * j + 1]) + (h[j][2] * wq[e][4 * j + 2] + h[j][3] * wq[e][4 * j + 3]);
                lg[e] = wave_sum(a); }
            int e0 = 0; float v0 = lg[0];
#pragma unroll
            for (int e = 1; e < NE; ++e) if (lg[e] > v0) { v0 = lg[e]; e0 = e; }
            int e1 = -1; float v1 = -3.0e38f;
#pragma unroll
            for (int e = 0; e < NE; ++e) if (e != e0 && lg[e] > v1) { v1 = lg[e]; e1 = e; }
            const float ex = expf(v1 - v0), g0 = 1.0f / (1.0f + ex), g1 = ex / (1.0f + ex);
            if (F.lane == 0) {
                const int r0 = atomicAdd((int*)&lcnt[e0], 1), r1 = atomicAdd((int*)&lcnt[e1], 1);
                lrow[lr * 4 + 0] = e0; lrow[lr * 4 + 1] = r0; lrow[lr * 4 + 2] = e1; lrow[lr * 4 + 3] = r1;
                *(f32x2*)(F.ws + WS_TOPG + (size_t)row * 8) = (f32x2){g0, g1};
            }
        }
    }
    if (MODE == 2) {
        __syncthreads();
        unsigned* gc = F.ctl() + CW_CNT + (l >> 1) * NE * 64;
        if (F.tid < NE) lcnt[8 + F.tid] = (int)atomicAdd(gc + F.tid * 64, (unsigned)lcnt[F.tid]);
        __syncthreads();
        for (int k0 = 0; k0 < steps; k0 += 64) { const int k = k0 + F.lane;
            if (k < steps) { const int row = ROWOF(k), lr2 = F.wave + NWAVES * k;
                const int e0 = lrow[lr2 * 4 + 0], p0 = lcnt[8 + e0] + lrow[lr2 * 4 + 1], e1 = lrow[lr2 * 4 + 2], p1 = lcnt[8 + e1] + lrow[lr2 * 4 + 3];
                *(int4*)(F.ws + WS_TOPE + (size_t)row * 16) = make_int4(e0, p0, e1, p1);
                int* list = (int*)(F.ws + WS_LIST); float* rsc = (float*)(F.ws + WS_RSC); const float hsr = F.HS()[row];
                list[(size_t)e0 * NTOK + p0] = row; list[(size_t)e1 * NTOK + p1] = row; rsc[(size_t)e0 * NTOK + p0] = hsr; rsc[(size_t)e1 * NTOK + p1] = hsr;
            }
        }
    }
#undef ROWOF
#undef YLOAD
}

__device__ __forceinline__ void phase_sgu(const Ctx& F, int l, int nchunks, int u0, int ustride) {
    constexpr int VP = 136;
    LAS bf16_t* VT = (LAS bf16_t*)F.lds;
    const int lane = F.lane, r32 = lane & 31, hi = lane >> 5, w = F.wave;
    const float* lng = F.in[I_SLNG] + l * 256, * lnb = F.in[I_SLNB] + l * 256;
    const bf16_t* Wb = F.wsm(l, SM_SGU);
    const float* sb = F.in[I_SGUB] + l * 4 * 128;
    const f32x4 g4 = *(const f32x4*)(lng + 4 * lane), b4 = *(const f32x4*)(lnb + 4 * lane);
    bf16x8 wa0[8], wa1[8];
    { const bf16_t* Wh0 = Wb + (size_t)(w >> 1) * 128 * 128 + (size_t)((w & 1) * 64 + r32) * 128 + hi * 8;
#pragma unroll
      for (int ks = 0; ks < 8; ++ks) { wa0[ks] = *(const bf16x8*)(Wh0 + ks * 16); wa1[ks] = *(const bf16x8*)(Wh0 + 32 * 128 + ks * 16); } }
    for (int cu = u0; cu < nchunks; cu += ustride) {
        const int tok0 = cu * 128;
        for (int q = w * 16; q < w * 16 + 16; ++q) {
            const u32x2 raw = *(const u32x2*)(F.ZIN() + (size_t)(tok0 + q) * ZP + ZV + 4 * lane);
            float x0 = __uint_as_float(raw.x << 16), x1 = __uint_as_float(raw.x & 0xffff0000u), x2 = __uint_as_float(raw.y << 16), x3 = __uint_as_float(raw.y & 0xffff0000u);
            const float mean = wave_sum((x0 + x1) + (x2 + x3)) * (1.0f / 256.0f);
            x0 -= mean; x1 -= mean; x2 -= mean; x3 -= mean;
            const float rstd = 1.0f / sqrtf(wave_sum((x0 * x0 + x1 * x1) + (x2 * x2 + x3 * x3)) * (1.0f / 256.0f) + EPS);
            const int qs = q ^ ((lane & 15) << 3);
            VT[(4 * lane + 0) * VP + qs] = f2bf(x0 * rstd * g4[0] + b4[0]); VT[(4 * lane + 1) * VP + qs] = f2bf(x1 * rstd * g4[1] + b4[1]);
            VT[(4 * lane + 2) * VP + qs] = f2bf(x2 * rstd * g4[2] + b4[2]); VT[(4 * lane + 3) * VP + qs] = f2bf(x3 * rstd * g4[3] + b4[3]);
        }
        __syncthreads();
        const int hh = w >> 1, ph = w & 1;
        f32x16 acc[2][2];
#pragma unroll
        for (int a = 0; a < 2; ++a)
#pragma unroll
            for (int b = 0; b < 2; ++b) acc[a][b] = f32x16{};
        const LAS bf16_t* Vh = VT + (hh * 64 + r32) * VP;
        const int sw0 = ((r32 >> 2) & 15) << 3, sw1 = (((r32 >> 2) + 8) & 15) << 3;
#pragma unroll
        for (int ks = 0; ks < 8; ++ks) {
            const bf16x8 a0 = wa0[ks], a1 = wa1[ks];
            const bf16x8 b0 = *(const LAS bf16x8*)(Vh + ((ks * 16 + hi * 8) ^ sw0)), b1 = *(const LAS bf16x8*)(Vh + 32 * VP + ((ks * 16 + hi * 8) ^ sw1));
            acc[0][0] = __builtin_amdgcn_mfma_f32_32x32x16_bf16(b0, a0, acc[0][0], 0, 0, 0);
            acc[0][1] = __builtin_amdgcn_mfma_f32_32x32x16_bf16(b1, a0, acc[0][1], 0, 0, 0);
            acc[1][0] = __builtin_amdgcn_mfma_f32_32x32x16_bf16(b0, a1, acc[1][0], 0, 0, 0);
            acc[1][1] = __builtin_amdgcn_mfma_f32_32x32x16_bf16(b1, a1, acc[1][1], 0, 0, 0);
        }
#pragma unroll
        for (int mb = 0; mb < 2; ++mb) {
            const int pp = ph * 64 + mb * 32 + r32; const float bias = sb[hh * 128 + pp]; const size_t tok = (size_t)(tok0 + pp);
#pragma unroll
            for (int nb = 0; nb < 2; ++nb)
#pragma unroll
                for (int g = 0; g < 4; g += 2) {
                    unsigned x[4], y[4];
#pragma unroll
                    for (int j = 0; j < 4; ++j) { x[j] = __float_as_uint(acc[mb][nb][4 * g + j] + bias); y[j] = __float_as_uint(acc[mb][nb][4 * g + 4 + j] + bias); pl32swap(x[j], y[j]); }
                    const int ch = hh * 64 + nb * 32 + (g + hi) * 8;
                    const u32x4 ur = *(const u32x4*)(F.ZIN() + tok * ZP + ZU + ch);
                    f32x4 v0, v1;
                    v0[0] = __uint_as_float(ur[0] << 16) * __uint_as_float(x[0]); v0[1] = __uint_as_float(ur[0] & 0xffff0000u) * __uint_as_float(x[1]);
                    v0[2] = __uint_as_float(ur[1] << 16) * __uint_as_float(x[2]); v0[3] = __uint_as_float(ur[1] & 0xffff0000u) * __uint_as_float(x[3]);
                    v1[0] = __uint_as_float(ur[2] << 16) * __uint_as_float(y[0]); v1[1] = __uint_as_float(ur[2] & 0xffff0000u) * __uint_as_float(y[1]);
                    v1[2] = __uint_as_float(ur[3] << 16) * __uint_as_float(y[2]); v1[3] = __uint_as_float(ur[3] & 0xffff0000u) * __uint_as_float(y[3]);
                    *(u32x4*)(F.MIX() + tok * DM + ch) = pack8(v0, v1);
                }
        }
        __syncthreads();
    }
}

__device__ __forceinline__ float neg_expm1(float z) {
    if (z > -0.25f) { return -z * (1.0f + z * (0.5f + z * ((1.0f / 6.0f) + z * ((1.0f / 24.0f) + z * ((1.0f / 120.0f) + z * (1.0f / 720.0f)))))); }
    return 1.0f - fast_exp2(1.4426950408889634f * z);
}

template <int PASS, int DIR>
__device__ __forceinline__ void lru_scan(const float (&av)[16], const float (&bv)[16], int hi, float (&hout)[16], unsigned char* ws, size_t idx) {
    float GA[4], GB[4], PA[4], PB[4];
#pragma unroll
    for (int g = 0; g < 4; ++g) { float A = 1.f, B = 0.f;
#pragma unroll
        for (int ii = 0; ii < 4; ++ii) { constexpr int dummy = 0; const int i = DIR ? 3 - ii : ii; A = A * av[4 * g + i]; B = B * av[4 * g + i] + bv[4 * g + i]; (void)dummy; }
        GA[g] = A; GB[g] = B; PA[g] = xor32_f(A); PB[g] = xor32_f(B); }
    const bool first = DIR ? (hi == 1) : (hi == 0);
    if (PASS == 1) {
        float A = 1.f, B = 0.f;
#pragma unroll
        for (int gg = 0; gg < 4; ++gg) { const int g = DIR ? 3 - gg : gg;
            const float A1 = first ? GA[g] : PA[g], B1 = first ? GB[g] : PB[g], A2 = first ? PA[g] : GA[g], B2 = first ? PB[g] : GB[g];
            B = B * A1 + B1; A = A * A1; B = B * A2 + B2; A = A * A2; }
        if (hi == 0) *(f32x2*)(ws + WS_AGG + idx * 8) = (f32x2){A, B};
    } else {
        float h = ((const float*)(ws + WS_CARRY))[idx];
#pragma unroll
        for (int gg = 0; gg < 4; ++gg) { const int g = DIR ? 3 - gg : gg;
            const float A1 = first ? GA[g] : PA[g], B1 = first ? GB[g] : PB[g], A2 = first ? PA[g] : GA[g], B2 = first ? PB[g] : GB[g];
            const float hmid = h * A1 + B1;
            float hc = first ? h : hmid;
            h = hmid * A2 + B2;
#pragma unroll
            for (int ii = 0; ii < 4; ++ii) { const int i = DIR ? 3 - ii : ii; hc = hc * av[4 * g + i] + bv[4 * g + i]; hout[4 * g + i] = hc; }
        }
    }
}
template <int PASS>
__device__ __forceinline__ void phase_lru(const Ctx& F, int l, int nseg_total, int u0, int ustride) {
    constexpr int XCP = 264;
    LAS float* XB = (LAS float*)F.lds;
    LAS float* XCF = (LAS float*)(F.lds + 36864);
    LAS bf16_t* XC = (LAS bf16_t*)(F.lds + 36864 + 32768);
    const int tid = F.tid, lane = F.lane, r32 = lane & 31, hi = lane >> 5, w = F.wave, hh = w >> 1, dir = w & 1;
    const float* cw = F.in[I_CONVW] + l * 4 * 256, * cb = F.in[I_CONVB] + l * 256;
    const bf16_t* GW = F.wsm(l, SM_GW);
    const float* c8p = (const float*)(F.ws + WS_C8) + (l * 2 + dir) * 256;
    const float* bap = F.in[I_LBA] + (l * 2 + dir) * 256, * bxp = F.in[I_LBX] + (l * 2 + dir) * 256;
    for (int sg = u0; sg < nseg_total; sg += ustride) {
        const int r0 = sg * 32;
        int seq0, slen, b, sidx;
        if (r0 < NLAT) { b = r0 >> 12; seq0 = b << 12; slen = SEQ; sidx = 8 + ((r0 - seq0) >> 5); }
        else { b = (r0 - NLAT) >> 8; seq0 = NLAT + (b << 8); slen = LC; sidx = (r0 - seq0) >> 5; }
        for (int i = tid; i < 35 * 32; i += NTHR) {
            const int rr = i >> 5, c8 = (i & 31) * 8; const int row = r0 - 2 + rr;
            f32x4 lo = {0.f, 0.f, 0.f, 0.f}, hi4 = {0.f, 0.f, 0.f, 0.f};
            if (row >= seq0 && row < seq0 + slen) { const u32x4 raw = *(const u32x4*)(F.ZIN() + (size_t)row * ZP + ZX + c8);
                lo[0] = __uint_as_float(raw.x << 16); lo[1] = __uint_as_float(raw.x & 0xffff0000u); lo[2] = __uint_as_float(raw.y << 16); lo[3] = __uint_as_float(raw.y & 0xffff0000u);
                hi4[0] = __uint_as_float(raw.z << 16); hi4[1] = __uint_as_float(raw.z & 0xffff0000u); hi4[2] = __uint_as_float(raw.w << 16); hi4[3] = __uint_as_float(raw.w & 0xffff0000u); }
            *(LAS f32x4*)(XB + rr * 256 + c8) = lo; *(LAS f32x4*)(XB + rr * 256 + c8 + 4) = hi4;
        }
        __syncthreads();
        {
            const int t = tid >> 4, c0 = (tid & 15) * 16;
#pragma unroll
            for (int q = 0; q < 4; ++q) {
                const int c = c0 + 4 * q;
                f32x4 a = *(const f32x4*)(cb + c);
#pragma unroll
                for (int j = 0; j < 4; ++j) a = a + *(const f32x4*)(cw + j * 256 + c) * *(const LAS f32x4*)(XB + (t + j) * 256 + c);
                *(LAS f32x4*)(XCF + t * 256 + c) = a;
                u32x2 pk; pk.x = cvt_pk_bf16(a[0], a[1]); pk.y = cvt_pk_bf16(a[2], a[3]);
                *(LAS u32x2*)(XC + t * XCP + c) = pk;
            }
        }
        __syncthreads();
        f32x16 acc[2][2];
#pragma unroll
        for (int a = 0; a < 2; ++a)
#pragma unroll
            for (int jb = 0; jb < 2; ++jb) acc[a][jb] = f32x16{};
#pragma unroll
        for (int ks = 0; ks < 4; ++ks) {
            const bf16x8 af = *(const LAS bf16x8*)(XC + r32 * XCP + hh * 64 + ks * 16 + hi * 8);
#pragma unroll
            for (int gt = 0; gt < 2; ++gt)
#pragma unroll
                for (int jb = 0; jb < 2; ++jb) {
                    const bf16x8 bfr = *(const bf16x8*)(GW + (size_t)((dir * 2 + gt) * 4 + hh) * 4096 + (size_t)(jb * 32 + r32) * 64 + ks * 16 + hi * 8);
                    acc[gt][jb] = __builtin_amdgcn_mfma_f32_32x32x16_bf16(af, bfr, acc[gt][jb], 0, 0, 0);
                }
        }
        float hout[2][16];
#pragma unroll
        for (int jb = 0; jb < 2; ++jb) {
            const int ch = hh * 64 + jb * 32 + r32;
            const float ba = bap[ch], bx = bxp[ch], c8 = c8p[ch];
            float av[16], bv[16];
#pragma unroll
            for (int r = 0; r < 16; ++r) {
                const int t = crow(r, hi);
                const float ra = sigmoid_f(acc[0][jb][r] + ba), ix = sigmoid_f(acc[1][jb][r] + bx);
                const float la = c8 * ra;
                av[r] = fast_exp2(1.4426950408889634f * la);
                bv[r] = sqrtf(neg_expm1(2.0f * la)) * (ix * XCF[t * 256 + ch]);
            }
            if (dir) lru_scan<PASS, 1>(av, bv, hi, hout[jb], F.ws, (((size_t)b * NSEG + sidx) * 2 + 1) * 256 + ch);
            else     lru_scan<PASS, 0>(av, bv, hi, hout[jb], F.ws, (((size_t)b * NSEG + sidx) * 2 + 0) * 256 + ch);
        }
        if (PASS == 2) {
            LAS float* HS = XB;
            if (dir == 0) {
#pragma unroll
                for (int jb = 0; jb < 2; ++jb)
#pragma unroll
                    for (int r = 0; r < 16; ++r) HS[crow(r, hi) * 256 + hh * 64 + jb * 32 + r32] = hout[jb][r];
            }
            __syncthreads();
            if (dir == 1) {
#pragma unroll
                for (int jb = 0; jb < 2; ++jb)
#pragma unroll
                    for (int r = 0; r < 16; ++r) HS[crow(r, hi) * 256 + hh * 64 + jb * 32 + r32] += hout[jb][r];
            }
            __syncthreads();
            {
                const int t = tid >> 4, c0 = (tid & 15) * 16; const size_t row = (size_t)(r0 + t);
#pragma unroll
                for (int q = 0; q < 2; ++q) {
                    const int c = c0 + 8 * q;
                    const u32x4 raw = *(const u32x4*)(F.ZIN() + row * ZP + ZG + c);
                    const f32x4 h0 = *(const LAS f32x4*)(HS + t * 256 + c), h1 = *(const LAS f32x4*)(HS + t * 256 + c + 4);
                    f32x4 y0, y1;
                    y0[0] = __uint_as_float(raw.x << 16) * h0[0]; y0[1] = __uint_as_float(raw.x & 0xffff0000u) * h0[1]; y0[2] = __uint_as_float(raw.y << 16) * h0[2]; y0[3] = __uint_as_float(raw.y & 0xffff0000u) * h0[3];
                    y1[0] = __uint_as_float(raw.z << 16) * h1[0]; y1[1] = __uint_as_float(raw.z & 0xffff0000u) * h1[1]; y1[2] = __uint_as_float(raw.w << 16) * h1[2]; y1[3] = __uint_as_float(raw.w & 0xffff0000u) * h1[3];
                    *(u32x4*)(F.MIX() + row * DM + 256 + c) = pack8(y0, y1);
                }
            }
        }
        __syncthreads();
    }
}
__device__ __forceinline__ void phase_lru_carry(const Ctx& F, int b) {
    const int dir = F.tid >> 8, ch = F.tid & 255;
    float h = 0.f;
    for (int step = 0; step < NSEG; ++step) {
        const int sidx = dir ? (step < 8 ? 7 - step : NSEG - 1 - (step - 8)) : step;
        const size_t idx = (((size_t)b * NSEG + sidx) * 2 + dir) * 256 + ch;
        ((float*)(F.ws + WS_CARRY))[idx] = h;
        const f32x2 ab = *(const f32x2*)(F.ws + WS_AGG + idx * 8);
        h = ab[0] * h + ab[1];
    }
}

template <int PASS>
__device__ __forceinline__ void phase_lru_w(const Ctx& F, int l, int nseg_total) {
    constexpr int RP = 72, XP = 68, WBYTES = 35 * RP * 2 + 32 * XP * 4;
    static_assert(WBYTES % 16 == 0, "wave LDS region 16-B aligned");
    LAS float* CWL = (LAS float*)F.lds;
    LAS float* GPL = (LAS float*)(F.lds + 5120);
    LAS unsigned char* wl = F.lds + 5120 + 6144 + F.wave * WBYTES;
    LAS bf16_t* RAW = (LAS bf16_t*)wl; LAS float* XCV = (LAS float*)(wl + 35 * RP * 2);
    const int lane = F.lane, r32 = lane & 31, hi = lane >> 5;
    for (int i = F.tid; i < 5 * 256; i += NTHR) CWL[i] = (i < 1024) ? F.in[I_CONVW][l * 1024 + i] : F.in[I_CONVB][l * 256 + i - 1024];
    for (int i = F.tid; i < 2 * 3 * 256; i += NTHR) { const int dir = i / 768, w = (i / 256) % 3, ch = i & 255; const int gi = (l * 2 + dir) * 256 + ch;
        GPL[i] = (w == 0) ? -1.4426950408889634f * F.in[I_LBA][gi] : (w == 1) ? -1.4426950408889634f * F.in[I_LBX][gi] : 1.4426950408889634f * ((const float*)(F.ws + WS_C8))[gi]; }
    __syncthreads();
    const bf16_t* GW = F.wsm(l, SM_GW);
    const int rbid = (PASS == 2 && F.G % 8 == 0) ? ((F.bid & 7) ^ 4) * (F.G >> 3) + (F.bid >> 3) : (F.bid + F.G / 4) % F.G;
    const int gw = rbid * NWAVES + F.wave, NGW = F.G * NWAVES;
    for (int u = gw; u < nseg_total * 4; u += NGW) {
        const int sg = u >> 2, hh = u & 3, r0 = sg * 32;
        int seq0, slen, b, sidx;
        if (r0 < NLAT) { b = r0 >> 12; seq0 = b << 12; slen = SEQ; sidx = 8 + ((r0 - seq0) >> 5); }
        else { b = (r0 - NLAT) >> 8; seq0 = NLAT + (b << 8); slen = LC; sidx = (r0 - seq0) >> 5; }
#pragma unroll
        for (int i = 0; i < 5; ++i) {
            const int rr = (lane >> 3) + 8 * i, row = r0 - 2 + rr; u32x4 raw = {0u, 0u, 0u, 0u};
            if (rr < 35 && row >= seq0 && row < seq0 + slen) raw = *(const u32x4*)(F.ZIN() + (size_t)row * ZP + ZX + hh * 64 + (lane & 7) * 8);
            if (rr < 35) *(LAS u32x4*)(RAW + rr * RP + (lane & 7) * 8) = raw;
        }
        asm volatile("s_waitcnt lgkmcnt(0)" ::: "memory");
        bf16x8 afr[4];
#pragma unroll
        for (int ks = 0; ks < 4; ++ks) {
            const int c = ks * 16 + hi * 8, cg = hh * 64 + c;
            f32x4 a0 = *(const LAS f32x4*)(CWL + 1024 + cg), a1 = *(const LAS f32x4*)(CWL + 1024 + cg + 4);
#pragma unroll
            for (int j = 0; j < 4; ++j) {
                const u32x4 raw = *(const LAS u32x4*)(RAW + (r32 + j) * RP + c);
                const f32x4 w0 = *(const LAS f32x4*)(CWL + j * 256 + cg), w1 = *(const LAS f32x4*)(CWL + j * 256 + cg + 4);
                a0[0] += w0[0] * __uint_as_float(raw.x << 16); a0[1] += w0[1] * __uint_as_float(raw.x & 0xffff0000u); a0[2] += w0[2] * __uint_as_float(raw.y << 16); a0[3] += w0[3] * __uint_as_float(raw.y & 0xffff0000u);
                a1[0] += w1[0] * __uint_as_float(raw.z << 16); a1[1] += w1[1] * __uint_as_float(raw.z & 0xffff0000u); a1[2] += w1[2] * __uint_as_float(raw.w << 16); a1[3] += w1[3] * __uint_as_float(raw.w & 0xffff0000u);
            }
            const u32x4 pk = pack8(a0, a1); afr[ks] = __builtin_bit_cast(bf16x8, pk);
            *(LAS f32x4*)(XCV + r32 * XP + c) = a0; *(LAS f32x4*)(XCV + r32 * XP + c + 4) = a1;
        }
        asm volatile("s_waitcnt lgkmcnt(0)" ::: "memory");
        float xd[2][16];
#pragma unroll
        for (int jb = 0; jb < 2; ++jb)
#pragma unroll
            for (int r = 0; r < 16; ++r) xd[jb][r] = XCV[crow(r, hi) * XP + jb * 32 + r32];
        float hsum[2][16];
#pragma unroll
        for (int dir = 0; dir < 2; ++dir) {
            f32x16 acc[2][2];
#pragma unroll
            for (int a = 0; a < 2; ++a)
#pragma unroll
                for (int jb = 0; jb < 2; ++jb) acc[a][jb] = f32x16{};
#pragma unroll
            for (int ks = 0; ks < 4; ++ks)
#pragma unroll
                for (int gt = 0; gt < 2; ++gt)
#pragma unroll
                    for (int jb = 0; jb < 2; ++jb) {
                        const bf16x8 bfr = *(const bf16x8*)(GW + (size_t)((dir * 2 + gt) * 4 + hh) * 4096 + (size_t)(jb * 32 + r32) * 64 + ks * 16 + hi * 8);
                        acc[gt][jb] = __builtin_amdgcn_mfma_f32_32x32x16_bf16(afr[ks], bfr, acc[gt][jb], 0, 0, 0);
                    }
#pragma unroll
            for (int jb = 0; jb < 2; ++jb) {
                const int ch = hh * 64 + jb * 32 + r32;
                const float nba = GPL[dir * 768 + ch], nbx = GPL[dir * 768 + 256 + ch], k8 = GPL[dir * 768 + 512 + ch];
                float av[16], bv[16], ho[16];
#pragma unroll
                for (int r = 0; r < 16; ++r) {
                    const float ra = fast_rcp(1.0f + fast_exp2(__builtin_fmaf(acc[0][jb][r], -1.4426950408889634f, nba)));
                    const float ix = fast_rcp(1.0f + fast_exp2(__builtin_fmaf(acc[1][jb][r], -1.4426950408889634f, nbx)));
                    const float a = fast_exp2(k8 * ra);
                    av[r] = a; bv[r] = __builtin_amdgcn_sqrtf((1.0f - a) * (1.0f + a)) * (ix * xd[jb][r]);
                }
                const size_t idx = (((size_t)b * NSEG + sidx) * 2 + dir) * 256 + ch;
                if (dir) lru_scan<PASS, 1>(av, bv, hi, ho, F.ws, idx); else lru_scan<PASS, 0>(av, bv, hi, ho, F.ws, idx);
                if (PASS == 2) {
#pragma unroll
                    for (int r = 0; r < 16; ++r) hsum[jb][r] = dir ? hsum[jb][r] + ho[r] : ho[r];
                }
            }
        }
        if (PASS == 2) {
#pragma unroll
            for (int jb = 0; jb < 2; ++jb)
#pragma unroll
                for (int r = 0; r < 16; ++r) XCV[crow(r, hi) * XP + jb * 32 + r32] = hsum[jb][r];
            asm volatile("s_waitcnt lgkmcnt(0)" ::: "memory");
            const int t = lane >> 1, c0 = (lane & 1) * 32; const size_t row = (size_t)(r0 + t);
#pragma unroll
            for (int q = 0; q < 4; ++q) {
                const int c = c0 + 8 * q;
                const u32x4 raw = *(const u32x4*)(F.ZIN() + row * ZP + ZG + hh * 64 + c);
                const f32x4 h0 = *(const LAS f32x4*)(XCV + t * XP + c), h1 = *(const LAS f32x4*)(XCV + t * XP + c + 4);
                f32x4 y0, y1;
                y0[0] = __uint_as_float(raw.x << 16) * h0[0]; y0[1] = __uint_as_float(raw.x & 0xffff0000u) * h0[1]; y0[2] = __uint_as_float(raw.y << 16) * h0[2]; y0[3] = __uint_as_float(raw.y & 0xffff0000u) * h0[3];
                y1[0] = __uint_as_float(raw.z << 16) * h1[0]; y1[1] = __uint_as_float(raw.z & 0xffff0000u) * h1[1]; y1[2] = __uint_as_float(raw.w << 16) * h1[2]; y1[3] = __uint_as_float(raw.w & 0xffff0000u) * h1[3];
                *(u32x4*)(F.MIX() + row * DM + 256 + hh * 64 + c) = pack8(y0, y1);
            }
            asm volatile("s_waitcnt lgkmcnt(0)" ::: "memory");
        }
    }
    __syncthreads();
}

namespace att {
constexpr int QBLK = 32, KVBLK = 64;
constexpr float SCALE = 0.10206207261596577f;
constexpr float THR = 8.f;
constexpr int SHM_K = KVBLK * 256, SHM_V = KVBLK * 64 * 2;
constexpr int LDS_BYTES = 4 * SHM_V + 4 * SHM_K + NWAVES * 64 * 4;
#define KSWZ(row, colB) ((row) * 256 + ((colB) ^ (((row) & 7) << 4)))
#define SBAR() __builtin_amdgcn_sched_barrier(0)
constexpr float PSH = 5.f;
constexpr float THR2 = PSH + 3.5f;
template <bool FIRST>
__device__ __forceinline__ void partialSM(f32x16& p0, f32x16& p1, float& m_reg, f32x16& negm, float& alpha) {
    float pmax = fmaxf(p0[0], p1[0]);
#pragma unroll
    for (int r = 1; r < 16; ++r) pmax = fmaxf(fmaxf(pmax, p0[r]), p1[r]);
    pmax = max32_f(pmax);
    alpha = 1.f;
    if (FIRST || !__all(pmax <= THR2)) {
        const float dl = FIRST ? pmax - PSH : fmaxf(pmax - PSH, 0.f);
        m_reg += dl; alpha = FIRST ? 1.f : __builtin_amdgcn_exp2f(-dl);
#pragma unroll
        for (int r = 0; r < 16; ++r) { p0[r] -= dl; p1[r] -= dl; negm[r] = -m_reg; }
    }
#pragma unroll
    for (int r = 0; r < 16; ++r) p0[r] = __builtin_amdgcn_exp2f(p0[r]);
}
__device__ __forceinline__ void finishSM(f32x16& p0, f32x16& p1, long& pa0, long& pa1, long& pa2, long& pa3) {
#pragma unroll
    for (int r = 0; r < 16; ++r) p1[r] = __builtin_amdgcn_exp2f(p1[r]);
#define PK4(P, BASE, OUT) do { int x, y; asm volatile("" : "=v"(x), "=v"(y));              \
    x = __builtin_amdgcn_cvt_pk_fp8_f32(P[BASE + 0], P[BASE + 1], x, false); x = __builtin_amdgcn_cvt_pk_fp8_f32(P[BASE + 2], P[BASE + 3], x, true); \
    y = __builtin_amdgcn_cvt_pk_fp8_f32(P[BASE + 4], P[BASE + 5], y, false); y = __builtin_amdgcn_cvt_pk_fp8_f32(P[BASE + 6], P[BASE + 7], y, true); \
    unsigned ux = (unsigned)x, uy = (unsigned)y; pl32swap(ux, uy); OUT = (long)(((unsigned long long)uy << 32) | (unsigned long long)ux); } while (0)
    PK4(p0, 0, pa0); PK4(p0, 8, pa1); PK4(p1, 0, pa2); PK4(p1, 8, pa3);
#undef PK4
}
#define KSWZ16(row, colB) ((row) * 128 + (((((colB) >> 4) ^ ((row) & 7))) << 4) + ((colB) & 15))
typedef long l64x4 __attribute__((ext_vector_type(4)));
#define MFMA64(A8, B8, C) __builtin_amdgcn_mfma_scale_f32_32x32x64_f8f6f4(__builtin_bit_cast(i32x8, A8), __builtin_bit_cast(i32x8, B8), C, 0, 0, 0, 0x7f7f7f7f, 0, 0x7f7f7f7f)
typedef unsigned u32x8 __attribute__((ext_vector_type(8)));
__device__ __forceinline__ void qkt(f32x16& p0, f32x16& p1, const LAS char* Ks, const u32x8& q8, const long* qr, const f32x16& negm, int r32, int hi) {
    const u32x4 a0l = *(const LAS u32x4*)(Ks + KSWZ16(r32, hi * 32)), a0h = *(const LAS u32x4*)(Ks + KSWZ16(r32, hi * 32 + 16));
    const u32x4 a1l = *(const LAS u32x4*)(Ks + KSWZ16(32 + r32, hi * 32)), a1h = *(const LAS u32x4*)(Ks + KSWZ16(32 + r32, hi * 32 + 16));
    const u32x4 r0 = *(const LAS u32x4*)(Ks + KSWZ16(r32, 64 + hi * 16)), r1 = *(const LAS u32x4*)(Ks + KSWZ16(32 + r32, 64 + hi * 16));
    const u32x8 a0 = __builtin_shufflevector(a0l, a0h, 0, 1, 2, 3, 4, 5, 6, 7), a1 = __builtin_shufflevector(a1l, a1h, 0, 1, 2, 3, 4, 5, 6, 7);
    p0 = MFMA64(a0, q8, negm); p1 = MFMA64(a1, q8, negm);
    p0 = __builtin_amdgcn_mfma_f32_32x32x16_fp8_fp8((long)(((unsigned long long)r0[1] << 32) | r0[0]), qr[0], p0, 0, 0, 0);
    p1 = __builtin_amdgcn_mfma_f32_32x32x16_fp8_fp8((long)(((unsigned long long)r1[1] << 32) | r1[0]), qr[0], p1, 0, 0, 0);
    p0 = __builtin_amdgcn_mfma_f32_32x32x16_fp8_fp8((long)(((unsigned long long)r0[3] << 32) | r0[2]), qr[1], p0, 0, 0, 0);
    p1 = __builtin_amdgcn_mfma_f32_32x32x16_fp8_fp8((long)(((unsigned long long)r1[3] << 32) | r1[2]), qr[1], p1, 0, 0, 0);
}
constexpr int SHM_V8 = 8 * 512, VB8 = 2 * SHM_V8;
template <int D0> __device__ __forceinline__ void pv_one(f32x16& od, int vb, long pa0, long pa1, long pa2, long pa3) {
    const long v0 = *(const LAS long*)(size_t)(unsigned)(vb + D0 * 256), v1 = *(const LAS long*)(size_t)(unsigned)(vb + D0 * 256 + 1024);
    const long v2 = *(const LAS long*)(size_t)(unsigned)(vb + D0 * 256 + 2048), v3 = *(const LAS long*)(size_t)(unsigned)(vb + D0 * 256 + 3072);
    const l64x4 p4 = {pa0, pa1, pa2, pa3}, v4 = {v0, v1, v2, v3};
    od = MFMA64(v4, p4, od);
}
__device__ __forceinline__ void pv_d0(f32x16* o, int vb, long pa0, long pa1, long pa2, long pa3, const l64x4& ones4) {
    pv_one<0>(o[0], vb, pa0, pa1, pa2, pa3); pv_one<1>(o[1], vb, pa0, pa1, pa2, pa3);
    const l64x4 p4 = {pa0, pa1, pa2, pa3}; o[2] = MFMA64(ones4, p4, o[2]);
}

__device__ __forceinline__ void attn_unit(const bf16_t* Qg, const unsigned char* VT8g, const unsigned char* K8g, const unsigned char* R8g, bf16_t* MIXg,
                                          int qrow0, int b, int h, int NT2, bool ctxq, LAS char* lds, int tid) {
    const int wid = tid >> 6, lane = tid & 63, r32 = lane & 31, hi = lane >> 5;
    constexpr int VB = VB8, KB = 2 * SHM_K;
    LAS char* V_lds = lds; LAS char* K_lds = lds + 4 * SHM_V;
    float m_reg = 0.f; f32x16 o[3] = {}; f32x16 negm = f32x16{};
    l64x4 ones4 = {0x3838383838383838L, 0x3838383838383838L, 0x3838383838383838L, 0x3838383838383838L}; asm volatile("" : "+v"(ones4));
    const unsigned char* Qw = (const unsigned char*)Qg + (size_t)(qrow0 + wid * QBLK + r32) * QP + h * DQK;
    const u32x4 q8l = *reinterpret_cast<const u32x4*>(Qw + hi * 32), q8h = *reinterpret_cast<const u32x4*>(Qw + hi * 32 + 16);
    const u32x8 q8 = __builtin_shufflevector(q8l, q8h, 0, 1, 2, 3, 4, 5, 6, 7);
    long qr[2]; { const u32x4 t = *reinterpret_cast<const u32x4*>(Qw + 64 + hi * 16); qr[0] = (long)(((unsigned long long)t[1] << 32) | t[0]); qr[1] = (long)(((unsigned long long)t[3] << 32) | t[2]); }
    const int srow = tid >> 3, sc8 = (tid & 7) * 8, rrow = tid >> 2, rc8 = (tid & 3) * 8;
    const int vkg = tid >> 5, vdp = tid & 31, vst = vkg * 512 + vdp * 16, kst = KSWZ16(srow, sc8), rst = (rrow >> 6) * SHM_K + KSWZ16(rrow & 63, 64 + rc8);
    const int vb0 = (int)(unsigned)(size_t)V_lds + r32 * 8 + hi * 512;
    const int kbase_lat = b * SEQ, kbase_ctx = NLAT + b * LC;
#define KROW(T) (ctxq ? kbase_ctx + (T) * 128 : ((T) < 32 ? kbase_lat + (T) * 128 : kbase_ctx + ((T) - 32) * 128))
    u32x4 sv; u32x2 sk0, sk1, sr;
#define SLOAD(T) do { const size_t _r = (size_t)KROW(T); \
    sk0 = *reinterpret_cast<const u32x2*>(K8g + (_r + srow) * 512 + h * 64 + sc8); sk1 = *reinterpret_cast<const u32x2*>(K8g + (_r + 64 + srow) * 512 + h * 64 + sc8); \
    sv = *reinterpret_cast<const u32x4*>(VT8g + ((_r >> 3) + vkg) * 4096 + (size_t)(h * 64 + 2 * vdp) * 8); \
    sr = *reinterpret_cast<const u32x2*>(R8g + (_r + rrow) * 32 + rc8); } while (0)
#define SWRITE(bf) do { *(LAS u32x4*)(V_lds + (bf) * VB + vst) = sv; \
    *(LAS u32x2*)(K_lds + (bf) * KB + kst) = sk0; *(LAS u32x2*)(K_lds + (bf) * KB + SHM_K + kst) = sk1; *(LAS u32x2*)(K_lds + (bf) * KB + rst) = sr; } while (0)
#define RESC(a) do { if (__any((a) < 1.f)) { _Pragma("unroll") for (int d = 0; d < 3; ++d) _Pragma("unroll") for (int r = 0; r < 16; ++r) o[d][r] *= (a); } } while (0)
    f32x16 pA0, pA1, pB0, pB1; float alA, alB; long pa0, pa1, pa2, pa3;
    SLOAD(0); SWRITE(0); if (1 < NT2) SLOAD(1);
    __syncthreads();
    qkt(pA0, pA1, K_lds, q8, qr, negm, r32, hi); partialSM<true>(pA0, pA1, m_reg, negm, alA);
    if (1 < NT2) { SWRITE(1); if (2 < NT2) SLOAD(2); }
    SBAR(); qkt(pB0, pB1, K_lds + SHM_K, q8, qr, negm, r32, hi);
    finishSM(pA0, pA1, pa0, pa1, pa2, pa3); SBAR();
    pv_d0(o, vb0, pa0, pa1, pa2, pa3, ones4); partialSM<false>(pB0, pB1, m_reg, negm, alB); RESC(alB);
    int pb = 0, cb = 1, nb = 2;
    asm volatile(".p2align 8" ::: "memory");
    for (int T = 1; T < NT2; ++T) {
        __syncthreads();
        SBAR(); qkt(pA0, pA1, K_lds + cb * KB, q8, qr, negm, r32, hi);
        finishSM(pB0, pB1, pa0, pa1, pa2, pa3); SBAR();
        pv_d0(o, vb0 + pb * VB + SHM_V8, pa0, pa1, pa2, pa3, ones4); partialSM<false>(pA0, pA1, m_reg, negm, alA); RESC(alA);
        if (T + 1 < NT2) { SWRITE(nb); if (T + 2 < NT2) SLOAD(T + 2); }
        SBAR(); qkt(pB0, pB1, K_lds + cb * KB + SHM_K, q8, qr, negm, r32, hi);
        finishSM(pA0, pA1, pa0, pa1, pa2, pa3); SBAR();
        pv_d0(o, vb0 + cb * VB, pa0, pa1, pa2, pa3, ones4); partialSM<false>(pB0, pB1, m_reg, negm, alB); RESC(alB);
        const int t_ = pb; pb = cb; cb = nb; nb = t_;
    }
    finishSM(pB0, pB1, pa0, pa1, pa2, pa3); SBAR();
    pv_d0(o, vb0 + pb * VB + SHM_V8, pa0, pa1, pa2, pa3, ones4);
    const float rl = __builtin_amdgcn_rcpf(o[2][0]);
    bf16_t* Ow = MIXg + (size_t)(qrow0 + wid * QBLK + r32) * DM + 512 + h * 64 + hi * 8;
#pragma unroll
    for (int d0 = 0; d0 < 2; ++d0)
#pragma unroll
        for (int g = 0; g < 4; g += 2) {
            unsigned a0 = cvt_pk_bf16(o[d0][4 * g] * rl, o[d0][4 * g + 1] * rl), a1 = cvt_pk_bf16(o[d0][4 * g + 2] * rl, o[d0][4 * g + 3] * rl);
            unsigned b0 = cvt_pk_bf16(o[d0][4 * g + 4] * rl, o[d0][4 * g + 5] * rl), b1 = cvt_pk_bf16(o[d0][4 * g + 6] * rl, o[d0][4 * g + 7] * rl);
            pl32swap(a0, b0); pl32swap(a1, b1);
            *(u32x4*)(Ow + d0 * 32 + g * 8) = (u32x4){a0, a1, b0, b1};
        }
    __syncthreads();
#undef KROW
#undef SLOAD
#undef SWRITE
#undef RESC
}
#undef KSWZ
#undef SBAR
}

__device__ __forceinline__ void phase_attn(const Ctx& F, bool last) {
    LAS char* lds = (LAS char*)F.lds;
    const int v = (F.G % 8 == 0) ? (F.bid & 7) * (F.G >> 3) + (F.bid >> 3) : F.bid;
    const int nun = 2048 + (last ? 0 : 128);
#pragma nounroll
    for (int u = v; u < nun; u += F.G) {
        const bool ctxq = u >= 2048;
        const int uu = ctxq ? u - 2048 : u;
        const int b = ctxq ? (uu >> 3) : (uu >> 7), h = ctxq ? (uu & 7) : ((uu >> 4) & 7), qb = uu & 15;
        att::attn_unit(F.Q(), F.VT8(), F.K8(), F.R8(), F.MIX(), ctxq ? NLAT + b * LC : b * SEQ + qb * 256, b, h, ctxq ? 2 : 34, ctxq, lds, F.tid);
    }
}


constexpr int LDS_BYTES = 147456;
constexpr int XB_ST_OFF = LDS_BYTES - 64;
constexpr int NPH = 7 + 2 * MOE_NR;
constexpr int NSTEPS = 2 + DEPTH * NPH;

__device__ __forceinline__ void lru_carry_all(const Ctx& F) {
    LAS f32x2* cmp = (LAS f32x2*)F.lds;
    for (int c0 = F.bid * 32; c0 < NB * 2 * 256; c0 += F.G * 32) {
        const int j = F.tid & 31, pt = F.tid >> 5, c = c0 + j, b = c >> 9, dir = (c >> 8) & 1, ch = c & 255;
        f32x2 ab[17]; unsigned idx[17];
        if (F.tid < 256) {
#pragma unroll
            for (int k = 0; k < 17; ++k) { const int step = 17 * pt + k; const int sidx = dir ? (step < 8 ? 7 - step : NSEG - 1 - (step - 8)) : step;
                idx[k] = (unsigned)(((b * NSEG + sidx) * 2 + dir) * 256 + ch); ab[k] = *(const f32x2*)(F.ws + WS_AGG + (size_t)idx[k] * 8); }
            float A = 1.f, B = 0.f;
#pragma unroll
            for (int k = 0; k < 17; ++k) { B = ab[k][0] * B + ab[k][1]; A = A * ab[k][0]; }
            cmp[pt * 32 + j] = (f32x2){A, B};
        }
        __syncthreads();
        if (F.tid < 256) {
            float h = 0.f;
#pragma unroll
            for (int q = 0; q < 7; ++q) { const f32x2 m = cmp[q * 32 + j]; h = (q < pt) ? m[0] * h + m[1] : h; }
#pragma unroll
            for (int k = 0; k < 17; ++k) { ((float*)(F.ws + WS_CARRY))[idx[k]] = h; h = ab[k][0] * h + ab[k][1]; }
        }
        __syncthreads();
    }
}

__global__ void __launch_bounds__(NTHR, 2) mega_fwd(Params P) {
    extern __shared__ __attribute__((aligned(16))) unsigned char lds_raw[];
    Ctx F; F.in = P.in; F.out = P.out; F.ws = P.ws;
    F.tid = threadIdx.x; F.lane = F.tid & 63; F.wave = __builtin_amdgcn_readfirstlane(F.tid >> 6); F.G = gridDim.x; F.bid = blockIdx.x;
    F.lds = (LAS unsigned char*)lds_raw;
    volatile LAS unsigned* st = (volatile LAS unsigned*)(F.lds + XB_ST_OFF);
    if (F.tid < 4) st[F.tid] = 0u;
    __syncthreads();
    const int lo = P.ph_lo, hi = P.ph_hi;
    const int wave0 = __builtin_amdgcn_readfirstlane(threadIdx.x >> 6);
    XcdBarrier bar; bar.bar = F.ctl() + CW_BAR; bar.x = 0; bar.st = st;
    if (hi - lo > 1) bar = xcd_barrier_post(F.ctl() + CW_BAR, st);
#ifndef PH_MASK
#define PH_MASK 0xffffffffu
#endif
#define PHM(k) ((PH_MASK >> (k)) & 1u)
#ifndef REP_MASK
#define REP_MASK 0u
#endif
#define REPQ(k) ((REP_MASK >> (k)) & 1u)
#define IN(s) (lo <= (s) && (s) < hi)
#define SEAM(s) do { if ((s) + 1 < hi) { xcd_barrier(bar); if (REPQ(20)) xcd_barrier(bar); } } while (0)
#define OPQ() do { int _t = wave0 * 64 + (int)__builtin_amdgcn_mbcnt_hi(~0u, __builtin_amdgcn_mbcnt_lo(~0u, 0u)); asm volatile("" : "+v"(_t)); F.tid = _t; F.lane = _t & 63; \
    unsigned long long _z = 0; int _w = wave0, _b = blockIdx.x, _g = gridDim.x; asm volatile("" : "+s"(_z), "+s"(_w), "+s"(_b), "+s"(_g)); F.ws = P.ws + _z; F.out = P.out + _z; F.wave = _w; F.bid = _b; F.G = _g; F.in = P.in + _z; F.lds = (LAS unsigned char*)lds_raw + (unsigned)_z; } while (0)

#define ARRIVE(w) do { asm volatile("s_waitcnt vmcnt(0)" ::: "memory"); __syncthreads(); \
        if (threadIdx.x == 0) { __builtin_amdgcn_fence(__ATOMIC_RELEASE, "agent"); asm volatile("s_waitcnt vmcnt(0)" ::: "memory"); (void)xb_add(F.ctl() + (w), 1u); } } while (0)
#define AWAIT(w) do { if (threadIdx.x == 0) { unsigned* cw = F.ctl() + (w); unsigned* bw = F.ctl() + CW_BAR; asm volatile("" : "+s"(cw), "+s"(bw)); \
        XB_SPIN(xb_ld(cw) != (unsigned)F.G, bw); __builtin_amdgcn_fence(__ATOMIC_ACQUIRE, "agent"); asm volatile("s_waitcnt vmcnt(0)" ::: "memory"); } __syncthreads(); } while (0)

    if (PHM(0) && IN(0)) { OPQ(); phase_prologue(F); if (REPQ(0)) { __syncthreads(); OPQ(); phase_prologue(F); } SEAM(0); }

    for (int l = 0; l < DEPTH; ++l) {
        const int s0 = 1 + l * NPH;
        if (hi <= s0 || lo >= s0 + NPH) continue;
        const bool last = (l == DEPTH - 1), moe = (l & 1);
        const int nrows = last ? NLAT : NTOK, nMr = nrows / 256;
        if (PHM(1) && IN(s0 + 0)) { OPQ();
            if (l == 0) phase_norm<0, true>(F, l, NTOK, false, 0); else phase_norm<0>(F, l, NTOK, (l == 2), 0);
            if (REPQ(1) && l != 2) { OPQ(); phase_norm<0>(F, l, NTOK, false, 0); }
            OPQ();
            if (l == 2) { __syncthreads(); cvt_moe_weights(F, 1, (LAS float*)(F.lds + F.wave * 16384)); OPQ(); cvt8_run(F, 1, (LAS float*)(F.lds + 135168)); }
            SEAM(s0 + 0);
        }
        if (PHM(2) && IN(s0 + 1)) { _Pragma("unroll") for (int _rp = 0; _rp < 1 + (int)REPQ(2); ++_rp) { OPQ();
            pg8::StaticOrder S; S.init(NTOK / 256, ZP / 256, F.G, F.bid);
            if constexpr (W_IN_I8) { pg8::Gemm g{(const bf16_t*)F.H8(), F.wsm(l, SM_IN), DM / 2, DM / 2};
                EpiIn E{F.ZIN(), F.SSP(), F.ROPE(), F.HS(), F.wsc(WSC_IN) + (size_t)l * ZP, F.R8()};
                pg8::gemm_phase<EpiIn, pg8::StaticOrder, false, 1>(F.lds, g, S, E, F.tid); }
            else { pg8::Gemm g{F.H(), F.wsm(l, SM_IN), DM, DM}; EpiInB E{F.ZIN(), F.SSP(), F.ROPE()};
                pg8::gemm_phase<EpiInB, pg8::StaticOrder, false, 0>(F.lds, g, S, E, F.tid); }
            } SEAM(s0 + 1);
        }
        if (PHM(3) && IN(s0 + 2)) { _Pragma("unroll") for (int _rp = 0; _rp < 1 + (int)REPQ(3); ++_rp) { OPQ();
            if (PHM(13)) { pg8::Gemm g{F.ZIN() + ZQ, F.wsm(l, SM_Q), QLORA, ZP}; pg8::StaticOrder S; S.init(NTOK / 256, QP / 256, F.G, F.bid);
              EpiQ E{F.Q(), F.SSP(), F.ROPE()}; pg8::gemm_phase<EpiQ, pg8::StaticOrder>(F.lds, g, S, E, F.tid);
              if (REPQ(13)) { OPQ(); pg8::gemm_phase<EpiQ, pg8::StaticOrder>(F.lds, g, S, E, F.tid); } }
            OPQ();
            if (PHM(14)) { pg8::Gemm g{F.ZIN() + ZKV, F.wsm(l, SM_KV), KVLORA, ZP}; pg8::StaticOrder S; S.init(NTOK / 256, 512 / 256, F.G, (F.bid + F.G - 48) % F.G);
              EpiKV E{F.KV(), F.SSP(), F.K8()}; pg8::gemm_phase<EpiKV, pg8::StaticOrder>(F.lds, g, S, E, F.tid);
              if (REPQ(14)) { OPQ(); pg8::gemm_phase<EpiKV, pg8::StaticOrder>(F.lds, g, S, E, F.tid); } }
            OPQ();
            if (PHM(14)) { pg8::Gemm g{F.wsm(l, SM_KV) + (size_t)512 * KVLORA, F.ZIN() + ZKV, KVLORA, KVLORA, ZP}; pg8::StaticOrder S; S.init(512 / 256, NTOK / 256, F.G, (F.bid + F.G - 80) % F.G);
              EpiVT E{F.VT8(), F.SSP()}; pg8::gemm_phase<EpiVT, pg8::StaticOrder>(F.lds, g, S, E, F.tid); }
            OPQ();
            if (PHM(16)) phase_lru_w<1>(F, l, NTOK / 32);
            if (REPQ(16)) { OPQ(); phase_lru_w<1>(F, l, NTOK / 32); }
            OPQ();
            if (PHM(15)) phase_sgu(F, l, last ? NLAT / 128 : NTOK / 128, (F.bid + F.G / 2) % F.G, F.G);
            if (REPQ(15)) { OPQ(); phase_sgu(F, l, last ? NLAT / 128 : NTOK / 128, F.bid, F.G); }
            xcd_barrier(bar);
            }
        }
        if (PHM(4) && IN(s0 + 3)) { _Pragma("unroll") for (int _rp = 0; _rp < 1 + (int)REPQ(4); ++_rp) { OPQ();
            if (PHM(17)) lru_carry_all(F);
            ARRIVE(CW_CARRY + l * 64);
            OPQ();
            if (PHM(18)) phase_attn(F, last);
            OPQ();
            AWAIT(CW_CARRY + l * 64);
            OPQ();
            if (PHM(5)) phase_lru_w<2>(F, l, last ? NLAT / 32 : NTOK / 32);
            } SEAM(s0 + 3);
        }
        if (PHM(6) && IN(s0 + 5)) { OPQ();
            pg8::Gemm g{F.MIX(), F.wsm(l, SM_OUT), DM, DM}; pg8::StaticOrder S; S.init(nMr, DM / 256, F.G, F.bid);
            EpiRes E{l == 0 ? F.in[I_X] : nullptr, l == 0 ? F.in[I_CTX] : nullptr, F.XB(), F.mod(l) + 2048, nullptr};
            pg8::gemm_phase<EpiRes, pg8::StaticOrder>(F.lds, g, S, E, F.tid);
            SEAM(s0 + 5);
        }
        if (PHM(7) && IN(s0 + 6)) { OPQ(); if (moe) phase_norm<2>(F, l, nrows, false, 0); else phase_norm<1>(F, l, nrows, false, 0); SEAM(s0 + 6); }
        if (!moe) {
            if (PHM(8) && IN(s0 + 7)) { _Pragma("unroll") for (int _rp = 0; _rp < 1 + (int)REPQ(8); ++_rp) { OPQ();
                pg8::Gemm g{(const bf16_t*)F.H8(), F.wffn(l >> 1, FF_13), DM / 2, DM / 2}; pg8::StaticOrder S; S.init(nMr, 2 * DFF / 256, F.G, F.bid);
                EpiGlu E{F.HMID(), DFF, F.HS(), F.wsc(WSC_FF) + (size_t)(l >> 1) * 2 * DFF, nullptr, nullptr, nullptr, 0, 1};
                pg8::gemm_phase<EpiGlu, pg8::StaticOrder, false, 1>(F.lds, g, S, E, F.tid);
                } SEAM(s0 + 7);
            }
            if (PHM(9) && IN(s0 + 8)) { OPQ();
                pg8::StaticOrder S; S.init(nMr, DM / 256, F.G, F.bid);
                if constexpr (DOWN_FP8) { pg8::Gemm g{F.HMID(), F.wffn(l >> 1, FF_2), DFF / 2, DFF / 2};
                    EpiRes E{nullptr, nullptr, F.XB(), F.mod(l) + 5120, F.wsc(WSC_F2) + (size_t)(l >> 1) * DM}; pg8::gemm_phase<EpiRes, pg8::StaticOrder, false, 2>(F.lds, g, S, E, F.tid); }
                else { pg8::Gemm g{F.HMID(), F.wffn(l >> 1, FF_2), DFF, DFF};
                    EpiRes E{nullptr, nullptr, F.XB(), F.mod(l) + 5120, nullptr}; pg8::gemm_phase<EpiRes, pg8::StaticOrder>(F.lds, g, S, E, F.tid); }
                SEAM(s0 + 8);
            }
        } else {
#pragma nounroll
            for (int r = 0; r < MOE_NR; ++r) {
                if (PHM(10) && IN(s0 + 7 + 2 * r)) { _Pragma("unroll") for (int _rp = 0; _rp < 1 + (int)REPQ(10); ++_rp) { OPQ();
                    LAS int* tab = (LAS int*)(F.lds + LDS_BYTES - 512); if (r == 0) moe_table(F, l >> 1, tab);
                    MoeOrder S; S.tab = tab; S.pm0 = r * MOE_RT; S.nN = 2 * DFE / 256; S.list = (const int*)(F.ws + WS_LIST);
                    int nM = __builtin_amdgcn_readfirstlane(tab[NE]) - S.pm0; nM = nM < 0 ? 0 : (nM > MOE_RT ? MOE_RT : nM); S.base.init(nM, S.nN, F.G, F.bid);
                    pg8::Gemm g{(const bf16_t*)F.H8(), F.wmoe(MO_13), DM / 2, DM / 2}; EpiGlu E{F.HMID(), DFE, F.HS(), F.wsc(WSC_MO), S.list, (const float*)(F.ws + WS_RSC), tab, S.pm0, S.nN};
                    pg8::gemm_phase<EpiGlu, MoeOrder, true, 1>(F.lds, g, S, E, F.tid);
                    } SEAM(s0 + 7 + 2 * r);
                }
                if (PHM(11) && IN(s0 + 8 + 2 * r)) { _Pragma("unroll") for (int _rp = 0; _rp < 1 + (int)REPQ(11); ++_rp) { OPQ();
                    LAS int* tab = (LAS int*)(F.lds + LDS_BYTES - 512);
                    MoeOrder S; S.tab = tab; S.pm0 = r * MOE_RT; S.nN = DM / 256; S.list = (const int*)(F.ws + WS_LIST);
                    int nM = __builtin_amdgcn_readfirstlane(tab[NE]) - S.pm0; nM = nM < 0 ? 0 : (nM > MOE_RT ? MOE_RT : nM); S.base.init(nM, S.nN, F.G, F.bid);
                    if constexpr (DOWN_FP8) { pg8::Gemm g{F.HMID(), F.wmoe(MO_2), DFE / 2, DFE / 2}; EpiBf E{F.YPAD(), DM, S.pm0, F.wsc(WSC_M2), S.nN};
                        pg8::gemm_phase<EpiBf, MoeOrder, false, 2>(F.lds, g, S, E, F.tid); }
                    else { pg8::Gemm g{F.HMID(), F.wmoe(MO_2), DFE, DFE}; EpiBf E{F.YPAD(), DM, S.pm0, nullptr, S.nN};
                        pg8::gemm_phase<EpiBf, MoeOrder, false, 0>(F.lds, g, S, E, F.tid); }
                    } SEAM(s0 + 8 + 2 * r);
                }
            }
        }
    }
    if (PHM(12) && IN(NSTEPS - 1)) { OPQ(); } if (PHM(12) && IN(NSTEPS - 1)) phase_norm<3>(F, DEPTH - 1, NLAT, true, 1);
#undef IN
#undef SEAM
}

#if CHECK
__device__ __forceinline__ unsigned hsh(unsigned x) { x ^= x >> 16; x *= 0x7feb352dU; x ^= x >> 15; x *= 0x846ca68bU; x ^= x >> 16; return x; }
__device__ __forceinline__ void ck_report(unsigned* slot, float got, float ref, float atol, float rtol) {
    float e = fabsf(got - ref) / (atol + rtol * fabsf(ref)); if (!(e == e)) e = 1e30f;
    atomicMax(slot, __float_as_uint(e));
}
__device__ __forceinline__ float rbf(float x) { return bf2f(f2bf(x)); }
__device__ __forceinline__ int rope_unperm(int pp) { const int half = pp >> 4, w = pp & 15, i = w >> 1, s = w & 1; return half * 16 + s * 8 + i; }
__device__ __forceinline__ float gelu_ref(float x) { return 0.5f * x * (1.0f + tanhf(0.7978845608028654f * (x + 0.044715f * x * x * x))); }
__device__ __forceinline__ float silu_ref(float x) { return x / (1.0f + expf(-x)); }
#define CKW(off) ((const bf16_t*)(P.ws + (off)))
struct CkP { const float* in[N_IN]; float* out; unsigned char* ws; };

__global__ void ck_mod(CkP P, unsigned* slot) {
    const unsigned t = blockIdx.x * blockDim.x + threadIdx.x; const unsigned r = hsh(t * 3 + 1);
    const int l = r & 3, b = (r >> 2) % 17, n = (r >> 8) % 6144;
    double a = 0; for (int k = 0; k < DM; ++k) { const float c = b < 16 ? P.in[I_C][b * DM + k] : P.in[I_CCTX][k]; a += (double)silu_ref(c) * P.in[I_WMOD][((size_t)l * DM + k) * 6144 + n]; }
    a += P.in[I_BMOD][l * 6144 + n];
    ck_report(slot, ((const float*)(P.ws + WS_MOD))[((size_t)l * 17 + b) * 6144 + n], (float)a, 2e-3f, 2e-3f);
}
__global__ void ck_wcvt(CkP P, int l, int mi, unsigned* slot) {
    const unsigned t = blockIdx.x * blockDim.x + threadIdx.x; const unsigned r = hsh(t * 7 + 5), r2 = hsh(r + 99);
    const size_t SMB = WS_WSM + (size_t)l * SM_BYTES;
    { const int n = r % ZP, k = r2 % DM; float ref = 0.f; if (n < D_IN) { const int c = n < ZR ? n : ZR + rope_unperm(n - ZR); ref = rbf(P.in[I_WIN][((size_t)l * DM + k) * D_IN + c]); }
      ck_report(slot, bf2f(CKW(SMB + SM_IN)[(size_t)n * DM + k]), ref, 1e-6f, 1e-6f); }
    { const int n = r % DM, k = r2 % DM; ck_report(slot, bf2f(CKW(SMB + SM_OUT)[(size_t)n * DM + k]), rbf(P.in[I_WOUT][((size_t)l * DM + k) * DM + n]), 1e-6f, 1e-6f); }
    { const int n = r % QP, k = r2 % QLORA; const int h = n / DQK, e = n % DQK, c = e < 64 ? n : h * DQK + 64 + rope_unperm(e - 64);
      ck_report(slot, bf2f(CKW(SMB + SM_Q)[(size_t)n * QLORA + k]), rbf(P.in[I_WUQ][((size_t)l * QLORA + k) * QP + c] * P.in[I_QN][l * QLORA + k]), 1e-6f, 1e-6f); }
    { const int n = r % KVP, k = r2 % KVLORA; const float w = n < 512 ? P.in[I_WUK][((size_t)l * KVLORA + k) * 512 + n] : P.in[I_WUV][((size_t)l * KVLORA + k) * 512 + n - 512];
      ck_report(slot, bf2f(CKW(SMB + SM_KV)[(size_t)n * KVLORA + k]), rbf(w * P.in[I_KVN][l * KVLORA + k]), 1e-6f, 1e-6f); }
    { const int idx = r % (4 * 128 * 128); ck_report(slot, bf2f(CKW(SMB + SM_SGU)[idx]), rbf(P.in[I_SGUW][(size_t)l * 4 * 128 * 128 + idx]), 1e-6f, 1e-6f); }
    { const int mat = r % 16, j = (r >> 4) % 64, i = r2 % 64, d = mat >> 3, gate = (mat >> 2) & 1, hh = mat & 3;
      const float w = (gate ? P.in[I_LWX] : P.in[I_LWA])[((((size_t)l * 2 + d) * 4 + hh) * 64 + i) * 64 + j];
      ck_report(slot, bf2f(CKW(SMB + SM_GW)[(size_t)mat * 4096 + j * 64 + i]), rbf(w), 1e-6f, 1e-6f); }
    if (!(l & 1)) { const int i = l >> 1; const size_t FB = WS_FFN + (size_t)i * FF_BYTES;
      { const int n = r % (2 * DFF), k = r2 % DM, tile = n >> 8, wi = n & 255, sec = wi >> 7, c = tile * 128 + (wi & 127);
        ck_report(slot, bf2f(CKW(FB + FF_13)[(size_t)n * DM + k]), rbf((sec ? P.in[I_F3] : P.in[I_F1])[((size_t)i * DM + k) * DFF + c]), 1e-6f, 1e-6f); }
      { const int n = r % DM, k = r2 % DFF; ck_report(slot, bf2f(CKW(FB + FF_2)[(size_t)n * DFF + k]), rbf(P.in[I_F2][((size_t)i * DFF + k) * DM + n]), 1e-6f, 1e-6f); } }
    if (mi >= 0) { const int e = (r >> 20) % NE;
      { const int n = r % (2 * DFE), k = r2 % DM, tile = n >> 8, wi = n & 255, sec = wi >> 7, c = tile * 128 + (wi & 127);
        ck_report(slot, bf2f(CKW(WS_MOE + MO_13)[((size_t)e * 2 * DFE + n) * DM + k]), rbf((sec ? P.in[I_M3] : P.in[I_M1])[(((size_t)mi * NE + e) * DM + k) * DFE + c]), 1e-6f, 1e-6f); }
      { const int n = r % DM, k = r2 % DFE; ck_report(slot, bf2f(CKW(WS_MOE + MO_2)[((size_t)e * DM + n) * DFE + k]), rbf(P.in[I_M2][(((size_t)mi * NE + e) * DFE + k) * DM + n]), 1e-6f, 1e-6f); } }
}
__device__ __forceinline__ const float* ck_xrow(const CkP& P, int row, bool first) {
    return row >= NLAT ? (first ? P.in[I_CTX] : (const float*)(P.ws + WS_XC)) + (size_t)(row - NLAT) * DM : (first ? P.in[I_X] : P.out) + (size_t)row * DM;
}
__global__ void ck_norm(CkP P, int l, int mode, int nrows, bool first, unsigned* slot) {
    const unsigned t = blockIdx.x * blockDim.x + threadIdx.x; const int row = hsh(t * 11 + 3) % nrows; const float* x = ck_xrow(P, row, first);
    double ss = 0; for (int k = 0; k < DM; ++k) ss += (double)x[k] * x[k];
    const float rstd = 1.0f / sqrtf((float)(ss / DM) + EPS); const int b = row >= NLAT ? 16 : row >> 12;
    const float* modl = (const float*)(P.ws + WS_MOD) + ((size_t)l * 17 + b) * 6144; const float* g = (mode == 0 ? P.in[I_N1G] : P.in[I_N2G]) + l * DM;
    for (int j = 0; j < 16; ++j) { const int c = hsh(t * 16 + j) % DM; const float h = x[c] * rstd * g[c] * (1.0f + modl[(mode == 0 ? 1024 : 4096) + c]) + modl[(mode == 0 ? 0 : 3072) + c];
        ck_report(slot, bf2f(((const bf16_t*)(P.ws + WS_H))[(size_t)row * DM + c]), h, 1e-2f, 1e-2f); }
}
__global__ void ck_win(CkP P, int l, unsigned* slot) {
    const unsigned t = blockIdx.x * blockDim.x + threadIdx.x; const unsigned r = hsh(t * 13 + 7);
    const int row = r % NTOK; int n = hsh(r) % D_IN; if (t & 1) n = ZR + (hsh(r) % 32);
    const bf16_t* H = (const bf16_t*)(P.ws + WS_H) + (size_t)row * DM; const bf16_t* W = CKW(WS_WSM + (size_t)l * SM_BYTES + SM_IN);
    auto dot = [&](int nn) { float a = 0; for (int k = 0; k < DM; ++k) a += bf2f(H[k]) * bf2f(W[(size_t)nn * DM + k]); return a; };
    float ref = dot(n);
    if (n < 768) ref = gelu_ref(ref);
    if (n >= ZR && row < NLAT) { const int pp = n - ZR, half = pp >> 4, i = (pp & 15) >> 1, s = pp & 1; const float other = dot(n ^ 1); const float x1 = s ? other : ref, x2 = s ? ref : other;
        const int tt = row & (SEQ - 1), pos = half ? (tt & 63) : (tt >> 6); const float ang = (float)pos * powf(10000.0f, -(float)(2 * i) / 16.0f); const float c = cosf(ang), sn = sinf(ang);
        ref = s ? (x1 * sn + x2 * c) : (x1 * c - x2 * sn); }
    ck_report(slot, bf2f(((const bf16_t*)(P.ws + WS_BIG + BG_ZIN))[(size_t)row * ZP + n]), ref, 2e-2f, 2e-2f);
}
__global__ void ck_qkv(CkP P, int l, unsigned* slotq, unsigned* slotkv) {
    const unsigned t = blockIdx.x * blockDim.x + threadIdx.x; const unsigned r = hsh(t * 17 + 9);
    const int row = r % NTOK; const bf16_t* Z = (const bf16_t*)(P.ws + WS_BIG + BG_ZIN) + (size_t)row * ZP;
    { double ss = 0; for (int k = 0; k < QLORA; ++k) { const float v = bf2f(Z[ZQ + k]); ss += (double)v * v; } const float rstd = 1.0f / sqrtf((float)(ss / QLORA) + EPS);
      const int h = hsh(r + 1) % HC, e = (t & 1) ? 64 + hsh(r + 2) % 32 : hsh(r + 2) % 64;
      auto qd = [&](int c) { float a = 0; for (int k = 0; k < QLORA; ++k) a += bf2f(Z[ZQ + k]) * rstd * P.in[I_QN][l * QLORA + k] * P.in[I_WUQ][((size_t)l * QLORA + k) * QP + c]; return a; };
      float ref; int nst;
      if (e < 64) { ref = qd(h * DQK + e); nst = h * DQK + e; }
      else { const int p = e - 64, half = p >> 4, w = p & 15, s = w >> 3, i = w & 7; const float x1 = qd(h * DQK + 64 + half * 16 + i), x2 = qd(h * DQK + 64 + half * 16 + 8 + i);
        if (row < NLAT) { const int tt = row & (SEQ - 1), pos = half ? (tt & 63) : (tt >> 6); const float ang = (float)pos * powf(10000.0f, -(float)(2 * i) / 16.0f); const float c = cosf(ang), sn = sinf(ang);
            ref = s ? (x1 * sn + x2 * c) : (x1 * c - x2 * sn); } else ref = s ? x2 : x1;
        nst = h * DQK + 64 + half * 16 + 2 * i + s; }
      ck_report(slotq, bf2f(((const bf16_t*)(P.ws + WS_BIG + BG_Q))[(size_t)row * QP + nst]), ref * QSCALE, 2e-2f * QSCALE, 2e-2f); }
    { double ss = 0; for (int k = 0; k < KVLORA; ++k) { const float v = bf2f(Z[ZKV + k]); ss += (double)v * v; } const float rstd = 1.0f / sqrtf((float)(ss / KVLORA) + EPS);
      const int n = hsh(r + 3) % KVP; float a = 0;
      for (int k = 0; k < KVLORA; ++k) a += bf2f(Z[ZKV + k]) * rstd * P.in[I_KVN][l * KVLORA + k] * (n < 512 ? P.in[I_WUK][((size_t)l * KVLORA + k) * 512 + n] : P.in[I_WUV][((size_t)l * KVLORA + k) * 512 + n - 512]);
      ck_report(slotkv, bf2f(((const bf16_t*)(P.ws + WS_BIG + BG_KV))[(size_t)row * KVP + n]), a, 2e-2f, 2e-2f); }
}
__global__ void ck_sgu(CkP P, int l, int ntok, unsigned* slot) {
    const unsigned t = blockIdx.x * blockDim.x + threadIdx.x; const unsigned r = hsh(t * 19 + 11);
    const int tok = r % ntok, ch = hsh(r) % 256, h = ch >> 6, p = tok & 127, tok0 = tok - p; const bf16_t* Z = (const bf16_t*)(P.ws + WS_BIG + BG_ZIN);
    float s = 0;
    for (int q = 0; q < 128; ++q) { const bf16_t* zr = Z + (size_t)(tok0 + q) * ZP + ZV; double m = 0, v2 = 0; for (int c = 0; c < 256; ++c) m += bf2f(zr[c]); m /= 256;
        for (int c = 0; c < 256; ++c) { const double d = bf2f(zr[c]) - m; v2 += d * d; } const float vn = (float)((bf2f(zr[ch]) - m) / sqrt(v2 / 256 + EPS)) * P.in[I_SLNG][l * 256 + ch] + P.in[I_SLNB][l * 256 + ch];
        s += P.in[I_SGUW][(((size_t)l * 4 + h) * 128 + p) * 128 + q] * vn; }
    s += P.in[I_SGUB][(l * 4 + h) * 128 + p];
    ck_report(slot, bf2f(((const bf16_t*)(P.ws + WS_BIG + BG_MIX))[(size_t)tok * DM + ch]), bf2f(Z[(size_t)tok * ZP + ZU + ch]) * s, 3e-2f, 3e-2f);
}
__global__ void ck_lru(CkP P, int l, bool last, unsigned* slot, float* tmp) {
    const unsigned t = blockIdx.x * blockDim.x + threadIdx.x; const unsigned r = hsh(t * 23 + 13);
    const int b = r % NB, ch = hsh(r) % 256, hh = ch >> 6, j = ch & 63; const bf16_t* Z = (const bf16_t*)(P.ws + WS_BIG + BG_ZIN);
    float* hf = tmp + (size_t)t * (SEQ + LC);
    auto rowof = [&](int pos) { return pos < LC ? NLAT + b * LC + pos : b * SEQ + (pos - LC); };
    auto xconv = [&](int pos, int c) { const bool isl = pos >= LC; const int tt = isl ? pos - LC : pos, len = isl ? SEQ : LC; float a = P.in[I_CONVB][l * 256 + c];
        for (int k = 0; k < 4; ++k) { const int ts = tt + k - 2; if (ts >= 0 && ts < len) a += P.in[I_CONVW][(l * 4 + k) * 256 + c] * bf2f(Z[(size_t)rowof(isl ? LC + ts : ts) * ZP + ZX + c]); } return a; };
    for (int d = 0; d < 2; ++d) {
        float h = 0.f; const float sp = log1pf(expf(-P.in[I_LAM][(l * 2 + d) * 256 + ch]));
        for (int step = 0; step < SEQ + LC; ++step) {
            const int pos = d == 0 ? step : (step < LC ? LC - 1 - step : LC + SEQ - 1 - (step - LC));
            float pa = P.in[I_LBA][(l * 2 + d) * 256 + ch], px = P.in[I_LBX][(l * 2 + d) * 256 + ch];
            for (int i = 0; i < 64; ++i) { const float xv = xconv(pos, hh * 64 + i); pa += xv * P.in[I_LWA][((((size_t)l * 2 + d) * 4 + hh) * 64 + i) * 64 + j]; px += xv * P.in[I_LWX][((((size_t)l * 2 + d) * 4 + hh) * 64 + i) * 64 + j]; }
            const float ra = 1.0f / (1.0f + expf(-pa)), ix = 1.0f / (1.0f + expf(-px)), la = -8.0f * ra * sp, a = expf(la), bv = sqrtf(-expm1f(2.0f * la)) * ix * xconv(pos, ch);
            h = a * h + bv;
            if (d == 0) hf[pos] = h;
            else if (pos >= LC || !last) { const int row = rowof(pos); ck_report(slot, bf2f(((const bf16_t*)(P.ws + WS_BIG + BG_MIX))[(size_t)row * DM + 256 + ch]), bf2f(Z[(size_t)row * ZP + ZG + ch]) * (hf[pos] + h), 3e-2f, 3e-2f); }
        }
    }
}
__global__ void ck_attn(CkP P, bool last, unsigned* slot) {
    const unsigned t = blockIdx.x * blockDim.x + threadIdx.x; const unsigned r = hsh(t * 29 + 17);
    const int row = r % (last ? NLAT : NTOK), h = hsh(r) % HC, d = hsh(r + 5) % 64; const bool cq = row >= NLAT; const int b = cq ? (row - NLAT) >> 8 : row >> 12;
    const bf16_t* Q = (const bf16_t*)(P.ws + WS_BIG + BG_Q) + (size_t)row * QP + h * DQK; const bf16_t* KV = (const bf16_t*)(P.ws + WS_BIG + BG_KV); const bf16_t* Z = (const bf16_t*)(P.ws + WS_BIG + BG_ZIN);
    const int nk = cq ? LC : SEQ + LC; double mx = -1e30, den = 0, num = 0;
    for (int pass = 0; pass < 2; ++pass) for (int kx = 0; kx < nk; ++kx) {
        const int kr = cq ? NLAT + b * LC + kx : (kx < SEQ ? b * SEQ + kx : NLAT + b * LC + kx - SEQ); double s = 0;
        for (int e = 0; e < 64; ++e) s += (double)bf2f(Q[e]) * bf2f(KV[(size_t)kr * KVP + h * 64 + e]);
        for (int e = 0; e < 32; ++e) s += (double)bf2f(Q[64 + e]) * bf2f(Z[(size_t)kr * ZP + ZR + e]);
        s *= 0.6931471805599453;
        if (pass == 0) mx = s > mx ? s : mx; else { const double pe = exp(s - mx); den += pe; num += pe * bf2f(KV[(size_t)kr * KVP + 512 + h * 64 + d]); } }
    ck_report(slot, bf2f(((const bf16_t*)(P.ws + WS_BIG + BG_MIX))[(size_t)row * DM + 512 + h * 64 + d]), (float)(num / den), 2e-2f, 3e-2f);
}
constexpr int NSNAP = 64;
__device__ __forceinline__ int snap_row(int s, int nrows) { return hsh(s * 31 + 19) % nrows; }
__global__ void ck_snap(CkP P, int nrows, bool first, float* snap) { const int s = blockIdx.x; const float* x = ck_xrow(P, snap_row(s, nrows), first); for (int c = threadIdx.x; c < DM; c += blockDim.x) snap[s * DM + c] = x[c]; }
__global__ void ck_res(CkP P, int l, int nrows, const bf16_t* A, int lda, int K, const float* W, int gate_off, const float* snap, unsigned* slot) {
    const int s = blockIdx.x, row = snap_row(s, nrows), c = hsh(s * 64 + threadIdx.x) % DM, b = row >= NLAT ? 16 : row >> 12;
    float a = 0; for (int k = 0; k < K; ++k) a += bf2f(A[(size_t)row * lda + k]) * W[(size_t)k * DM + c];
    const float ref = snap[s * DM + c] + ((const float*)(P.ws + WS_MOD))[((size_t)l * 17 + b) * 6144 + gate_off + c] * a;
    ck_report(slot, ck_xrow(P, row, false)[c], ref, 1e-2f, 1e-2f);
}
__global__ void ck_router(CkP P, int l, int nrows, unsigned* slot) {
    const unsigned t = blockIdx.x * blockDim.x + threadIdx.x; const int row = hsh(t * 37 + 23) % nrows, b = row >= NLAT ? 16 : row >> 12; const float* x = ck_xrow(P, row, false);
    double ss = 0; for (int k = 0; k < DM; ++k) ss += (double)x[k] * x[k]; const float rstd = 1.0f / sqrtf((float)(ss / DM) + EPS);
    const float* modl = (const float*)(P.ws + WS_MOD) + ((size_t)l * 17 + b) * 6144; double lg[NE] = {0, 0, 0, 0, 0, 0, 0, 0};
    for (int k = 0; k < DM; ++k) { const float h = x[k] * rstd * P.in[I_N2G][l * DM + k] * (1.0f + modl[4096 + k]) + modl[3072 + k]; for (int e = 0; e < NE; ++e) lg[e] += (double)h * P.in[I_ROUT][((size_t)(l >> 1) * DM + k) * NE + e]; }
    int e0 = 0; for (int e = 1; e < NE; ++e) if (lg[e] > lg[e0]) e0 = e; int e1 = e0 == 0 ? 1 : 0; for (int e = 0; e < NE; ++e) if (e != e0 && lg[e] > lg[e1]) e1 = e;
    double srt[NE]; for (int e = 0; e < NE; ++e) srt[e] = lg[e]; for (int i = 0; i < NE; ++i) for (int j = i + 1; j < NE; ++j) if (srt[j] > srt[i]) { const double tt = srt[i]; srt[i] = srt[j]; srt[j] = tt; }
    const int4 ep = *(const int4*)(P.ws + WS_TOPE + (size_t)row * 16); const f32x2 gg = *(const f32x2*)(P.ws + WS_TOPG + (size_t)row * 8);
    if (srt[1] - srt[2] > 1e-3 && srt[0] - srt[1] > 1e-3) { ck_report(slot, (float)ep.x, (float)e0, 0.5f, 0.f); ck_report(slot, (float)ep.z, (float)e1, 0.5f, 0.f);
        const double ex = exp(lg[e1] - lg[e0]); ck_report(slot, gg[0], (float)(1.0 / (1.0 + ex)), 2e-3f, 0.f); ck_report(slot, gg[1], (float)(ex / (1.0 + ex)), 2e-3f, 0.f); }
    const int* list = (const int*)(P.ws + WS_LIST); const unsigned* cnt = (const unsigned*)(P.ws + WS_CTL) + CW_CNT + (l >> 1) * NE * 64;
    ck_report(slot, (float)list[(size_t)ep.x * NTOK + ep.y], (float)row, 0.5f, 0.f); ck_report(slot, (float)list[(size_t)ep.z * NTOK + ep.w], (float)row, 0.5f, 0.f);
    ck_report(slot, (ep.y < (int)cnt[ep.x * 64] && ep.w < (int)cnt[ep.z * 64]) ? 0.f : 1.f, 0.f, 0.5f, 0.f);
    if (t == 0) { unsigned tot = 0; for (int e = 0; e < NE; ++e) tot += cnt[e * 64]; ck_report(slot, (float)tot, (float)(2 * nrows), 0.5f, 0.f); }
}
__global__ void ck_ffn_up(CkP P, int l, int nrows, unsigned* slot) {
    const unsigned t = blockIdx.x * blockDim.x + threadIdx.x; const unsigned r = hsh(t * 41 + 29); const int row = r % nrows, c = hsh(r) % DFF, i = l >> 1;
    const bf16_t* H = (const bf16_t*)(P.ws + WS_H) + (size_t)row * DM; float a = 0, g = 0;
    for (int k = 0; k < DM; ++k) { a += bf2f(H[k]) * P.in[I_F1][((size_t)i * DM + k) * DFF + c]; g += bf2f(H[k]) * P.in[I_F3][((size_t)i * DM + k) * DFF + c]; }
    ck_report(slot, bf2f(((const bf16_t*)(P.ws + WS_BIG + BG_HMID))[(size_t)row * DFF + c]), silu_ref(a) * g, 2e-2f, 3e-2f);
}
__global__ void ck_moe(CkP P, int l, int r, int which, unsigned* slot) {
    const unsigned t = blockIdx.x * blockDim.x + threadIdx.x; const unsigned rr = hsh(t * 43 + 31 + r); const int mi = l >> 1;
    const unsigned* cnt = (const unsigned*)(P.ws + WS_CTL) + CW_CNT + mi * NE * 64; int tp[NE + 1]; int acc = 0; for (int e = 0; e < NE; ++e) { tp[e] = acc; acc += ((int)cnt[e * 64] + 255) >> 8; } tp[NE] = acc;
    const int pm0 = r * MOE_RT, nM = min(max(acc - pm0, 0), MOE_RT); if (nM == 0) return;
    const int gpm = pm0 + rr % nM; int e = 0; for (int j = 1; j < NE; ++j) if (gpm >= tp[j]) e = j;
    const int pos = (gpm - tp[e]) * 256 + hsh(rr) % 256; const int tok = pos < (int)cnt[e * 64] ? ((const int*)(P.ws + WS_LIST))[(size_t)e * NTOK + pos] : 0;
    const size_t lrow = (size_t)(gpm - pm0) * 256 + (pos & 255);
    if (which == 0) { const int c = hsh(rr + 7) % DFE; const bf16_t* H = (const bf16_t*)(P.ws + WS_H) + (size_t)tok * DM; float a = 0, g = 0;
        for (int k = 0; k < DM; ++k) { a += bf2f(H[k]) * P.in[I_M1][(((size_t)mi * NE + e) * DM + k) * DFE + c]; g += bf2f(H[k]) * P.in[I_M3][(((size_t)mi * NE + e) * DM + k) * DFE + c]; }
        ck_report(slot, bf2f(((const bf16_t*)(P.ws + WS_BIG + BG_HMID))[lrow * DFE + c]), silu_ref(a) * g, 2e-2f, 3e-2f);
    } else { const int c = hsh(rr + 7) % DM; const bf16_t* A = (const bf16_t*)(P.ws + WS_BIG + BG_HMID) + lrow * DFE; float a = 0;
        for (int k = 0; k < DFE; ++k) a += bf2f(A[k]) * P.in[I_M2][(((size_t)mi * NE + e) * DFE + k) * DM + c];
        ck_report(slot, bf2f(((const bf16_t*)(P.ws + WS_BIG + BG_YPAD))[((size_t)gpm * 256 + (pos & 255)) * DM + c]), a, 2e-2f, 3e-2f); }
}
__global__ void ck_combine(CkP P, int lprev, int nrows, const float* snap, unsigned* slot) {
    const int s = blockIdx.x, row = snap_row(s, nrows), c = hsh(s * 64 + threadIdx.x + 1) % DM, b = row >= NLAT ? 16 : row >> 12, mi = lprev >> 1;
    const unsigned* cnt = (const unsigned*)(P.ws + WS_CTL) + CW_CNT + mi * NE * 64; int tp[NE + 1]; int acc = 0; for (int e = 0; e < NE; ++e) { tp[e] = acc; acc += ((int)cnt[e * 64] + 255) >> 8; }
    const int4 ep = *(const int4*)(P.ws + WS_TOPE + (size_t)row * 16); const f32x2 gg = *(const f32x2*)(P.ws + WS_TOPG + (size_t)row * 8); const bf16_t* Y = (const bf16_t*)(P.ws + WS_BIG + BG_YPAD);
    const float y = gg[0] * bf2f(Y[((size_t)tp[ep.x] * 256 + ep.y) * DM + c]) + gg[1] * bf2f(Y[((size_t)tp[ep.z] * 256 + ep.w) * DM + c]);
    ck_report(slot, ck_xrow(P, row, false)[c], snap[s * DM + c] + ((const float*)(P.ws + WS_MOD))[((size_t)lprev * 17 + b) * 6144 + 5120 + c] * y, 1e-3f, 1e-3f);
}
__global__ void ck_final(float* out, int n, const unsigned* chk, int nslots) {
    __shared__ int bad; if (threadIdx.x == 0) { bad = 0; for (int i = 1; i < nslots; ++i) if (__uint_as_float(chk[i]) > 1.0f) { bad = i; break; } } __syncthreads();
    if (bad == 0) return; const float c = sqrtf((float)bad * 1.0025f);
    for (int i = blockIdx.x * blockDim.x + threadIdx.x; i < n; i += gridDim.x * blockDim.x) out[i] = c;
}
#ifndef CK_ONLY
#define CK_ONLY 0
#endif
__global__ void ck_mag(float* out, int n, const unsigned* chk, int id) {
    const float e = __uint_as_float(chk[id]); const float c = sqrtf(fminf(e, 1e6f) * 1.0025f);
    for (int i = blockIdx.x * blockDim.x + threadIdx.x; i < n; i += gridDim.x * blockDim.x) out[i] = c;
}

static void run_checked(Params p, int grid, hipStream_t stream);
#endif
#if CHECK
static void run_checked(Params p, int grid, hipStream_t stream) {
    CkP c{}; for (int i = 0; i < N_IN; ++i) c.in[i] = p.in[i]; c.out = p.out; c.ws = p.ws;
    unsigned* chk = (unsigned*)(p.ws + WS_CTL) + CW_CHK;
    float* snap = (float*)(p.ws + WS_END + 4096); float* ltmp = snap + NSNAP * DM;
    auto run = [&](int s) { Params q = p; q.ph_lo = s; q.ph_hi = s + 1; hipLaunchKernelGGL(mega_fwd, dim3(grid), dim3(NTHR), LDS_BYTES, stream, q); };
#define SLOT(type, l) (chk + (type) * 4 + (l))
    run(0);
    ck_mod<<<4, 64, 0, stream>>>(c, SLOT(1, 0));
    for (int l = 0; l < DEPTH; ++l) ck_wcvt<<<16, 64, 0, stream>>>(c, l, 0, SLOT(2, l));
    for (int l = 0; l < DEPTH; ++l) {
        const int s0 = 1 + l * NPH; const bool last = l == DEPTH - 1, moe = l & 1; const int nrows = last ? NLAT : NTOK;
        if (l == 2) ck_snap<<<NSNAP, 64, 0, stream>>>(c, NTOK, false, snap);
        run(s0 + 0);
        if (l == 2) { ck_combine<<<NSNAP, 64, 0, stream>>>(c, 1, NTOK, snap, SLOT(19, 1)); ck_wcvt<<<16, 64, 0, stream>>>(c, l, 1, SLOT(2, l)); }
        ck_norm<<<2, 64, 0, stream>>>(c, l, 0, NTOK, l == 0, SLOT(3, l));
        run(s0 + 1); ck_win<<<8, 64, 0, stream>>>(c, l, SLOT(4, l));
        run(s0 + 2); ck_qkv<<<8, 64, 0, stream>>>(c, l, SLOT(5, l), SLOT(6, l)); ck_sgu<<<4, 64, 0, stream>>>(c, l, last ? NLAT : NTOK, SLOT(7, l));
        run(s0 + 3); ck_attn<<<4, 64, 0, stream>>>(c, last, SLOT(10, l));
        run(s0 + 4); ck_lru<<<1, 32, 0, stream>>>(c, l, last, SLOT(11, l), ltmp);
        ck_snap<<<NSNAP, 64, 0, stream>>>(c, nrows, l == 0, snap);
        run(s0 + 5); ck_res<<<NSNAP, 64, 0, stream>>>(c, l, nrows, (const bf16_t*)(p.ws + WS_BIG + BG_MIX), DM, DM, p.in[I_WOUT] + (size_t)l * DM * DM, 2048, snap, SLOT(12, l));
        run(s0 + 6); ck_norm<<<2, 64, 0, stream>>>(c, l, 1, nrows, false, SLOT(13, l));
        if (!moe) {
            run(s0 + 7); ck_ffn_up<<<8, 64, 0, stream>>>(c, l, nrows, SLOT(15, l));
            ck_snap<<<NSNAP, 64, 0, stream>>>(c, nrows, false, snap);
            run(s0 + 8); ck_res<<<NSNAP, 64, 0, stream>>>(c, l, nrows, (const bf16_t*)(p.ws + WS_BIG + BG_HMID), DFF, DFF, p.in[I_F2] + (size_t)(l >> 1) * DFF * DM, 5120, snap, SLOT(16, l));
        } else {
            ck_router<<<4, 64, 0, stream>>>(c, l, nrows, SLOT(14, l));
            for (int r = 0; r < MOE_NR; ++r) { run(s0 + 7 + 2 * r); ck_moe<<<8, 64, 0, stream>>>(c, l, r, 0, SLOT(17, l)); run(s0 + 8 + 2 * r); ck_moe<<<8, 64, 0, stream>>>(c, l, r, 1, SLOT(18, l)); }
        }
    }
    run(NSTEPS - 1);
#if CK_ONLY
    ck_mag<<<1024, 256, 0, stream>>>(p.out, NLAT * DM, chk, CK_ONLY);
#else
    ck_final<<<1024, 256, 0, stream>>>(p.out, NLAT * DM, chk, 80);
#endif
#undef SLOT
}
#endif

extern "C" void kernel_launch(void* const* d_in, const int* in_sizes, int n_in, void* d_out, int out_size, void* d_ws, size_t ws_size, hipStream_t stream) {
    static int grid = 0;
    if (grid == 0) {
        if (n_in != N_IN || in_sizes[0] != NLAT * DM || out_size != NLAT * DM || ws_size < WS_END + (CHECK ? (8u << 20) : 0)) {
            fprintf(stderr, "kernel_launch: shape mismatch: n_in %d in0 %d out %d ws %zu (need %zu)\n", n_in, n_in > 0 ? in_sizes[0] : -1, out_size, ws_size, (size_t)WS_END); grid = -1; return; }
        int dev = 0, cus = 0, per_cu = 0;
        if (hipGetDevice(&dev) != hipSuccess || hipDeviceGetAttribute(&cus, hipDeviceAttributeMultiprocessorCount, dev) != hipSuccess) { grid = -1; return; }
        if (hipFuncSetAttribute((const void*)mega_fwd, hipFuncAttributeMaxDynamicSharedMemorySize, LDS_BYTES) != hipSuccess) { fprintf(stderr, "kernel_launch: hipFuncSetAttribute failed\n"); grid = -1; return; }
        if (hipOccupancyMaxActiveBlocksPerMultiprocessor(&per_cu, (const void*)mega_fwd, NTHR, LDS_BYTES) != hipSuccess || per_cu < 1) { fprintf(stderr, "kernel_launch: occupancy query says %d\n", per_cu); }
        (void)hipGetLastError();
        grid = cus;
    }
    if (grid < 0) return;
    (void)hipMemsetAsync((char*)d_ws + WS_CTL, 0, CTL_BYTES, stream);
    Params p{};
    for (int i = 0; i < N_IN; ++i) p.in[i] = (const float*)d_in[i];
    p.out = (float*)d_out; p.ws = (unsigned char*)d_ws;
#if CHECK
    run_checked(p, grid, stream);
#else
    p.ph_lo = 0; p.ph_hi = NSTEPS;
    hipLaunchKernelGGL(mega_fwd, dim3(grid), dim3(NTHR), LDS_BYTES, stream, p);
#endif
}
```

```cpp
#include <hip/hip_runtime.h>
#include <cstdio>
#include <cstdint>

#ifndef DOWN_FP8
#define DOWN_FP8 0
#endif
#ifndef W_IN_I8
#define W_IN_I8 1
#endif
#ifndef CHECK
#define CHECK 0
#endif

#define LAS __attribute__((address_space(3)))
typedef unsigned short bf16_t;
typedef short bf16x8 __attribute__((ext_vector_type(8)));
typedef short s16x4 __attribute__((ext_vector_type(4)));
typedef float f32x4 __attribute__((ext_vector_type(4)));
typedef float f32x2 __attribute__((ext_vector_type(2)));
typedef float f32x16 __attribute__((ext_vector_type(16)));
typedef unsigned u32x4 __attribute__((ext_vector_type(4)));
typedef unsigned u32x2 __attribute__((ext_vector_type(2)));
typedef int i32x4 __attribute__((ext_vector_type(4)));
typedef int i32x8 __attribute__((ext_vector_type(8)));

constexpr int NB = 16, SEQ = 4096, LC = 256, DM = 1024, DEPTH = 4;
constexpr int NLAT = NB * SEQ, NCTX = NB * LC, NTOK = NLAT + NCTX;
constexpr int D_IN = 1696, ZP = 1792;
constexpr int ZU = 0, ZV = 256, ZG = 512, ZX = 768, ZQ = 1024, ZKV = 1408, ZR = 1664;
constexpr int QLORA = 384, KVLORA = 256, QP = 768, KVP = 1024, HC = 8, DQK = 96;
constexpr int DFF = 2816, DFE = 3584, NE = 8;
constexpr int NSEG = 136;
constexpr float EPS = 1e-6f;
constexpr int NWAVES = 8, NTHR = 512;

enum { I_X = 0, I_C, I_CTX, I_CCTX, I_WMOD, I_BMOD, I_N1G, I_N2G, I_WIN, I_WOUT, I_SLNG, I_SLNB, I_SGUW, I_SGUB, I_CONVW, I_CONVB,
       I_LWA, I_LBA, I_LWX, I_LBX, I_LAM, I_QN, I_WUQ, I_KVN, I_WUK, I_WUV, I_F1, I_F3, I_F2, I_ROUT, I_M1, I_M3, I_M2, I_FNG, N_IN };

constexpr size_t al256(size_t x) { return (x + 255) / 256 * 256; }
constexpr size_t WS_CTL = 0, CTL_BYTES = 1u << 20;
constexpr size_t WS_MOD = WS_CTL + CTL_BYTES;
constexpr size_t WS_ROPE = WS_MOD + al256((size_t)DEPTH * 17 * 6144 * 4);
constexpr size_t WS_C8 = WS_ROPE + al256(64 * 8 * 2 * 4);
constexpr size_t WS_SSP = WS_C8 + al256(DEPTH * 2 * 256 * 4);
constexpr size_t WS_AGG = WS_SSP + al256((size_t)NTOK * 16 * 4);
constexpr size_t WS_CARRY = WS_AGG + al256((size_t)NB * NSEG * 2 * 256 * 8);
constexpr size_t WS_TOPE = WS_CARRY + al256((size_t)NB * NSEG * 2 * 256 * 4);
constexpr size_t WS_TOPG = WS_TOPE + al256((size_t)NTOK * 16);
constexpr size_t WS_LIST = WS_TOPG + al256((size_t)NTOK * 8);
constexpr size_t WS_RSC = WS_LIST + al256((size_t)NE * NTOK * 4);
constexpr size_t WS_HS = WS_RSC + al256((size_t)NE * NTOK * 4);
constexpr size_t WS_WSC = WS_HS + al256((size_t)NTOK * 4);
constexpr size_t WSC_IN = 0, WSC_FF = (size_t)DEPTH * ZP * 4, WSC_MO = WSC_FF + (size_t)2 * 2 * DFF * 4, WSC_F2 = WSC_MO + (size_t)NE * 2 * DFE * 4  , WSC_M2 = WSC_F2 + (size_t)2 * DM * 4  ,
                 WSC_BYTES = al256(WSC_M2 + (size_t)NE * DM * 4);
constexpr size_t WS_XB = WS_WSC + WSC_BYTES;
constexpr size_t WS_K8 = WS_XB + al256((size_t)NTOK * DM * 2);
constexpr size_t WS_R8 = WS_K8 + al256((size_t)NTOK * 512);
constexpr size_t WS_VT8 = WS_R8 + al256((size_t)NTOK * 32);
constexpr size_t WS_WSM = WS_VT8 + al256((size_t)NTOK * 512);
constexpr size_t SM_IN = 0, SM_OUT = SM_IN + (size_t)ZP * DM * 2, SM_Q = SM_OUT + (size_t)DM * DM * 2, SM_KV = SM_Q + (size_t)QP * QLORA * 2,
                 SM_SGU = SM_KV + (size_t)KVP * KVLORA * 2, SM_GW = SM_SGU + (size_t)4 * 128 * 128 * 2, SM_BYTES = al256(SM_GW + (size_t)2 * 2 * 4 * 64 * 64 * 2);
constexpr size_t WS_FFN = WS_WSM + DEPTH * SM_BYTES;
constexpr size_t FF_13 = 0, FF_2 = (size_t)2 * DFF * DM * 2, FF_BYTES = FF_2 + (size_t)DM * DFF * 2;
constexpr size_t WS_MOE = WS_FFN + 2 * FF_BYTES;
constexpr size_t MO_13 = 0, MO_2 = (size_t)NE * 2 * DFE * DM * 2, MO_BYTES = MO_2 + (size_t)NE * DM * DFE * 2;
constexpr size_t WS_H = WS_MOE + MO_BYTES;
constexpr size_t WS_BIG = WS_H + (size_t)NTOK * DM * (W_IN_I8 ? 1 : 2);
constexpr size_t BG_ZIN = 0, BG_Q = BG_ZIN + (size_t)NTOK * ZP * 2, BG_KV = BG_Q + (size_t)NTOK * QP * 2, BG_MIX = BG_KV + (size_t)NTOK * KVP * 2,
                 BG_BYTES = BG_MIX + (size_t)NTOK * DM * 2;
constexpr int MOE_RT = 192;
constexpr size_t BG_HMID = 0, BG_YPAD = (size_t)MOE_RT * 256 * DFE * 2;
constexpr int MOE_MAXT = (2 * NTOK) / 256 + NE;
constexpr int MOE_NR = (MOE_MAXT + MOE_RT - 1) / MOE_RT;
static_assert(BG_YPAD + (size_t)MOE_MAXT * 256 * DM * 2 <= BG_BYTES, "YPAD fits");
static_assert((size_t)NTOK * DFF * 2 <= BG_BYTES, "dense HMID fits");
constexpr size_t WS_END = WS_BIG + BG_BYTES;
static_assert(WS_END < 1200000000ull, "workspace budget");

constexpr int CW_BAR = 4096;
constexpr int CW_CNT = 8192;
constexpr int CW_CARRY = 12288;
constexpr int CW_P2 = 13312;
constexpr int CW_CHK = 16384;

__device__ __forceinline__ float bf2f(bf16_t v) { return __uint_as_float(((unsigned)v) << 16); }
__device__ __forceinline__ unsigned cvt_pk_bf16(float lo, float hi) { unsigned r; asm volatile("v_cvt_pk_bf16_f32 %0, %1, %2" : "=v"(r) : "v"(lo), "v"(hi)); return r; }
__device__ __forceinline__ bf16_t f2bf(float f) { return (bf16_t)(cvt_pk_bf16(f, 0.f) & 0xffffu); }
__device__ __forceinline__ float fast_exp2(float x) { return __builtin_amdgcn_exp2f(x); }
__device__ __forceinline__ float fast_rcp(float x) { return __builtin_amdgcn_rcpf(x); }
__device__ __forceinline__ float sigmoid_f(float x) { return fast_rcp(1.0f + fast_exp2(-1.4426950408889634f * x)); }
__device__ __forceinline__ float silu_f(float x) { return x * sigmoid_f(x); }
__device__ __forceinline__ float gelu_tanh_f(float x) { const float u = 0.7978845608028654f * (x + 0.044715f * x * x * x); return x * sigmoid_f(2.0f * u); }
#define DPP_F(v, ctrl) __builtin_bit_cast(float, __builtin_amdgcn_update_dpp(0, __builtin_bit_cast(int, (v)), (ctrl), 0xf, 0xf, true))
__device__ __forceinline__ float xor16_f(float v) { return __builtin_bit_cast(float, __builtin_amdgcn_ds_swizzle(__builtin_bit_cast(int, v), 0x401f)); }
__device__ __forceinline__ void pl32swap(unsigned& a, unsigned& b) { asm volatile("s_nop 1\n\tv_permlane32_swap_b32 %0, %1\n\ts_nop 0" : "+v"(a), "+v"(b)); }
__device__ __forceinline__ float xor32_f(float v) {
    unsigned a = __builtin_bit_cast(unsigned, v), b = a; pl32swap(a, b);
    return (__builtin_amdgcn_mbcnt_hi(~0u, __builtin_amdgcn_mbcnt_lo(~0u, 0u)) < 32u) ? __builtin_bit_cast(float, b) : __builtin_bit_cast(float, a);
}
__device__ __forceinline__ float sum32_f(float v) {
    unsigned a = __builtin_bit_cast(unsigned, v), b = a; pl32swap(a, b);
    return __builtin_bit_cast(float, a) + __builtin_bit_cast(float, b);
}
__device__ __forceinline__ float max32_f(float v) {
    unsigned a = __builtin_bit_cast(unsigned, v), b = a; pl32swap(a, b);
    return fmaxf(__builtin_bit_cast(float, a), __builtin_bit_cast(float, b));
}
__device__ __forceinline__ float wave_max(float v) {
    v = fmaxf(v, DPP_F(v, 0xB1)); v = fmaxf(v, DPP_F(v, 0x4E)); v = fmaxf(v, DPP_F(v, 0x141)); v = fmaxf(v, DPP_F(v, 0x140));
    v = fmaxf(v, xor16_f(v));
    return max32_f(v);
}
__device__ __forceinline__ float wave_sum(float v) {
    v += DPP_F(v, 0xB1);
    v += DPP_F(v, 0x4E);
    v += DPP_F(v, 0x141);
    v += DPP_F(v, 0x140);
    v += xor16_f(v);
    return sum32_f(v);
}
__device__ __forceinline__ int crow(int r, int hi) { return (r & 3) + 8 * (r >> 2) + 4 * hi; }

#define XB_TMO      128
#define XB_XCNT(j)  (256  + 64 * (j))
#define XB_XSUB(j)  (1280 + 64 * (j))
#define XB_XGEN(j)  (2304 + 64 * (j))
#define XB_TOP      3328
#define XB_TOPGEN   3392
#define XCD_BAR_WORDS 3456
#define XB_SPIN_CAP (1u << 22)
__device__ __forceinline__ unsigned xb_ld(unsigned* p)              { return __hip_atomic_load(p, __ATOMIC_RELAXED, __HIP_MEMORY_SCOPE_AGENT); }
__device__ __forceinline__ unsigned xb_add(unsigned* p, unsigned v) { return __hip_atomic_fetch_add(p, v, __ATOMIC_RELAXED, __HIP_MEMORY_SCOPE_AGENT); }
__device__ __forceinline__ unsigned xb_xcc_id() { return (unsigned)__builtin_amdgcn_s_getreg((3 << 11) | 20) & 0xFu; }
#define XB_SPIN(cond, bar) do { unsigned _sp = 0; while (cond) { __builtin_amdgcn_s_sleep(1); \
    if ((++_sp & 255u) == 0u) { if (xb_ld(&(bar)[XB_TMO])) break; if (_sp > XB_SPIN_CAP) { atomicAdd(&(bar)[XB_TMO], 1u); break; } } } } while (0)
struct XcdBarrier { unsigned* bar; unsigned x; volatile LAS unsigned* st; };
__device__ __forceinline__ XcdBarrier xcd_barrier_post(unsigned* bar, volatile LAS unsigned* st) {
    XcdBarrier b; b.bar = bar; b.x = xb_xcc_id(); b.st = st;
    if (threadIdx.x == 0) (void)xb_add(&bar[XB_XCNT(b.x)], 1u);
    return b;
}
__device__ __forceinline__ void xcd_barrier_complete(unsigned* bar, unsigned x, unsigned& nloc, unsigned& nx) {
    const unsigned G = gridDim.x * gridDim.y * gridDim.z;
    unsigned sum, cnt, mine, sp = 0u;
    for (;;) {
        sum = 0u; cnt = 0u; mine = 0u;
#pragma unroll
        for (unsigned j = 0; j < 16; ++j) { const unsigned c = xb_ld(&bar[XB_XCNT(j)]); sum += c; cnt += (c > 0u) ? 1u : 0u; }
        if (sum == G) { mine = xb_ld(&bar[XB_XCNT(x)]); break; }
        __builtin_amdgcn_s_sleep(1);
        if ((++sp & 255u) == 0u) { if (xb_ld(&bar[XB_TMO])) break; if (sp > XB_SPIN_CAP) { atomicAdd(&bar[XB_TMO], 1u); break; } }
    }
    nloc = mine > 0u ? mine : 1u; nx = cnt > 0u ? cnt : 1u;
}
__device__ __forceinline__ void xcd_barrier(const XcdBarrier& b) {
    asm volatile("s_waitcnt vmcnt(0)" ::: "memory");
    __syncthreads();
    if (threadIdx.x == 0) {
        unsigned* bar = b.bar; asm volatile("" : "+s"(bar));
        __builtin_amdgcn_s_waitcnt(0);
        unsigned nloc = b.st[0], nx = b.st[1];
        if (nloc == 0u) { xcd_barrier_complete(bar, b.x, nloc, nx); b.st[0] = nloc; b.st[1] = nx; }
        const unsigned old = xb_add(&bar[XB_XSUB(b.x)], 1u);
        const unsigned gen = old / nloc;
        if (old + 1u == (gen + 1u) * nloc) {
            __builtin_amdgcn_fence(__ATOMIC_RELEASE, "agent");
            asm volatile("s_waitcnt vmcnt(0)" ::: "memory");
            const unsigned og = xb_add(&bar[XB_TOP], 1u);
            const unsigned tg = og / nx;
            if (og + 1u == (tg + 1u) * nx) xb_add(&bar[XB_TOPGEN], 1u);
            else XB_SPIN(xb_ld(&bar[XB_TOPGEN]) == tg, bar);
            __builtin_amdgcn_fence(__ATOMIC_ACQUIRE, "agent");
            xb_add(&bar[XB_XGEN(b.x)], 1u);
            asm volatile("s_waitcnt vmcnt(0)" ::: "memory");
        } else {
            XB_SPIN(xb_ld(&bar[XB_XGEN(b.x)]) == gen, bar);
            __builtin_amdgcn_fence(__ATOMIC_ACQUIRE, "agent");
            asm volatile("s_waitcnt vmcnt(0)" ::: "memory");
        }
    }
    __syncthreads();
}

namespace pg8 {
constexpr int BM = 256, BK = 64, HALF = 128, HTB = HALF * BK * 2, STAGE_BYTES = 8 * HTB, NXCD = 8, WGM = 4;
__host__ __device__ __forceinline__ int lds_byte(int r, int c) { const int st = (r >> 4) * 2 + (c >> 5), rr = r & 15, cc = c & 31, ob = rr * 64 + cc * 2; return st * 1024 + (ob ^ (((ob >> 9) & 1) << 5)); }
__host__ __device__ __forceinline__ void stage_rc(int b, int& R, int& C) { const int st = b / 1024, sb = b % 1024, swz = sb ^ (((sb >> 9) & 1) << 5); R = (st >> 1) * 16 + swz / 64; C = (st & 1) * 32 + (swz % 64) / 2; }
__host__ __device__ __forceinline__ int perm32(int rho) { const int n = rho >> 4, i = rho & 15; return 8 * (i >> 2) + 4 * n + (i & 3); }

struct Unit { int pm, pn, bn; };
struct Gemm { const bf16_t* A; const bf16_t* Bt; int K; int lda; int ldb = 0; };

struct StaticOrder {
    int nM, nN, nwg, G, c;
    __host__ __device__ void init(int nM_, int nN_, int G_, int c_) { nM = nM_; nN = nN_; nwg = nM * nN; G = G_; c = c_; }
    __host__ __device__ bool next(int i, Unit& u) const {
        const long L = (long)i * G + c; if (L >= nwg) return false;
        int wgid = (int)L; { const int q = nwg / NXCD, r = nwg % NXCD, xcd = wgid % NXCD, off = wgid / NXCD; wgid = (xcd < r ? xcd * (q + 1) : r * (q + 1) + (xcd - r) * q) + off; }
        const int nig = WGM * nN, gid = wgid / nig, fm = gid * WGM, gsz = (nM - fm) < WGM ? (nM - fm) : WGM;
        u.pm = fm + ((wgid % nig) % gsz); u.pn = (wgid % nig) / gsz; u.bn = u.pn; return true;
    }
    __device__ __forceinline__ void gather(const Unit&, int, int, unsigned (&)[2][2]) const {}
};

template <class Epi, class Sched, bool GATHER = false, int OPM = 0  , bool ALIGN_EPI = true, bool SP2 = true>
__device__ __forceinline__ void gemm_phase(LAS unsigned char* lds, const Gemm g, const Sched& S, const Epi& E, int tid) {
    const int wid = __builtin_amdgcn_readfirstlane(tid >> 6), lane = tid & 63, wr = wid >> 2, wc = wid & 3, fr = lane & 15, fq = lane >> 4;
    const int K = g.K, nt = K / BK, lda = g.lda, ldb = g.ldb ? g.ldb : g.K;
    unsigned voffA[2], voffB[2]; int stR[2], stC[2];
#pragma unroll
    for (int i = 0; i < 2; ++i) { int R, C; stage_rc(tid * 16 + i * 8192, R, C); const int Rb = Epi::PERM ? ((R & ~31) + perm32(R & 31)) : R;
        stR[i] = R; stC[i] = C; voffA[i] = (unsigned)(R * lda + C) * 2u; voffB[i] = (unsigned)(Rb * ldb + C) * 2u; }
    const size_t kstep = (size_t)(BK * 2);
    const size_t hstepA = GATHER ? 0 : (size_t)HALF * lda * 2, hstepB = (size_t)HALF * ldb * 2;
    const size_t tstepA = (size_t)BM * lda * 2, tstepB = 2 * hstepB;
    const unsigned ldsw = (unsigned)wid * 1024u;
    const int aoff = lds_byte(wr * 64 + fr, fq * 8), boff = lds_byte(wc * 32 + fr, fq * 8);
#define PG8_SA(b, h) (((b) * 2 + (h)) * HTB)
#define PG8_SB(b, h) ((4 + (b) * 2 + (h)) * HTB)
#define PG8_STAGE(bufoff, gbase, voff) do { _Pragma("unroll") for (int _i = 0; _i < 2; ++_i) \
        __builtin_amdgcn_global_load_lds((const unsigned*)((const char*)(gbase) + (voff)[_i]), (LAS unsigned*)(lds + (bufoff) + ldsw + _i * 8192), 16, 0, 0); } while (0)
#define PG8_LDA(dst, b, h) do { _Pragma("unroll") for (int m = 0; m < 4; ++m) _Pragma("unroll") for (int k = 0; k < 2; ++k) dst[m][k] = *(const LAS bf16x8*)(lds + PG8_SA(b, h) + aoff + m * 2048 + k * 1024); } while (0)
#define PG8_LDB(dst, b, h) do { _Pragma("unroll") for (int n = 0; n < 2; ++n) _Pragma("unroll") for (int k = 0; k < 2; ++k) dst[n][k] = *(const LAS bf16x8*)(lds + PG8_SB(b, h) + boff + n * 2048 + k * 1024); } while (0)
#define PG8_MMA(ai, bj, At, Bt) do { __builtin_amdgcn_s_setprio(1); _Pragma("unroll") for (int m = 0; m < 4; ++m) _Pragma("unroll") for (int n = 0; n < 2; ++n) _Pragma("unroll") for (int k = 0; k < 2; ++k) { \
        if constexpr (OPM == 1) acc[ai][bj][m][n] = __builtin_bit_cast(AccT, __builtin_amdgcn_mfma_i32_16x16x64_i8(__builtin_bit_cast(i32x4, Bt[n][k]), __builtin_bit_cast(i32x4, At[m][k]), __builtin_bit_cast(i32x4, acc[ai][bj][m][n]), 0, 0, 0)); \
        else acc[ai][bj][m][n] = __builtin_bit_cast(AccT, __builtin_amdgcn_mfma_f32_16x16x32_bf16(Bt[n][k], At[m][k], __builtin_bit_cast(f32x4, acc[ai][bj][m][n]), 0, 0, 0)); } __builtin_amdgcn_s_setprio(0); } while (0)
#define PG8_WAIT_V(n) asm volatile("s_waitcnt vmcnt(" #n ")" ::: "memory")
#define PG8_WAIT_L(n) asm volatile("s_waitcnt lgkmcnt(" #n ")" ::: "memory")
#define PG8_BAR __builtin_amdgcn_s_barrier()
#define PG8_SCHED __builtin_amdgcn_sched_barrier(0)
    Unit cur, nxt; int ui = 0;
    if (!S.next(0, cur)) return;
    using AccT = typename Epi::AccT;
    AccT acc[2][2][4][2];
#pragma unroll
    for (int a = 0; a < 2; ++a)
#pragma unroll
        for (int b = 0; b < 2; ++b)
#pragma unroll
            for (int m = 0; m < 4; ++m)
#pragma unroll
                for (int n = 0; n < 2; ++n) acc[a][b][m][n] = AccT{};
    bf16x8 At[4][2], B0[2][2], B1[2][2];
    unsigned gC[2][2], gN[2][2];
    const char* cA = GATHER ? (const char*)g.A : (const char*)g.A + (size_t)cur.pm * tstepA; const char* cB = (const char*)g.Bt + (size_t)cur.bn * tstepB;
    if constexpr (GATHER) { S.gather(cur, stR[0], stR[1], gC);
#pragma unroll
        for (int h = 0; h < 2; ++h)
#pragma unroll
            for (int i = 0; i < 2; ++i) { gC[h][i] = gC[h][i] * (unsigned)(lda * 2) + (unsigned)stC[i] * 2u; gN[h][i] = gC[h][i]; } }
#define PG8_STAGE_A(bufoff, p, h, off) do { if constexpr (GATHER) { PG8_STAGE(bufoff, p, (off)[h]); } else { PG8_STAGE(bufoff, (p) + (h) * hstepA, voffA); } } while (0)
    if constexpr (SP2) {
        PG8_STAGE(PG8_SB(0, 0), cB, voffB); PG8_STAGE(PG8_SB(0, 1), cB + hstepB, voffB); PG8_STAGE_A(PG8_SA(0, 0), cA, 0, gC); PG8_STAGE_A(PG8_SA(0, 1), cA, 1, gC);
        if (wr == 1) PG8_BAR;
        PG8_WAIT_V(2); PG8_BAR;
        PG8_STAGE(PG8_SB(1, 0), cB + kstep, voffB); PG8_STAGE_A(PG8_SA(1, 0), cA + kstep, 0, gC); PG8_STAGE(PG8_SB(1, 1), cB + hstepB + kstep, voffB);
        PG8_WAIT_V(6); PG8_BAR;
    } else {
        PG8_STAGE(PG8_SB(0, 0), cB, voffB); PG8_STAGE_A(PG8_SA(0, 0), cA, 0, gC); PG8_STAGE(PG8_SB(0, 1), cB + hstepB, voffB); PG8_STAGE_A(PG8_SA(0, 1), cA, 1, gC);
        if (wr == 1) PG8_BAR;
        PG8_WAIT_V(4); PG8_BAR;
        PG8_STAGE(PG8_SB(1, 0), cB + kstep, voffB); PG8_STAGE_A(PG8_SA(1, 0), cA + kstep, 0, gC); PG8_STAGE(PG8_SB(1, 1), cB + hstepB + kstep, voffB);
        PG8_WAIT_V(6); PG8_BAR;
    }
    for (;;) {
        const bool has_next = S.next(ui + 1, nxt);
        const char* nA = GATHER ? (const char*)g.A : (has_next ? (const char*)g.A + (size_t)nxt.pm * tstepA : cA);
        const char* nB = has_next ? (const char*)g.Bt + (size_t)nxt.bn * tstepB : cB;
        if constexpr (GATHER) {
            if (has_next) { S.gather(nxt, stR[0], stR[1], gN);
#pragma unroll
                for (int h = 0; h < 2; ++h)
#pragma unroll
                    for (int i = 0; i < 2; ++i) gN[h][i] = gN[h][i] * (unsigned)(lda * 2) + (unsigned)stC[i] * 2u; }
            else {
#pragma unroll
                for (int h = 0; h < 2; ++h)
#pragma unroll
                    for (int i = 0; i < 2; ++i) gN[h][i] = gC[h][i]; }
        }
#pragma nounroll
        for (int t = 0; t < nt; t += 2) {
            const bool last = (t == nt - 2);
            const char* a1 = cA + (size_t)(t + 1) * kstep;
            const char* a2 = last ? nA : cA + (size_t)(t + 2) * kstep; const char* b2 = last ? nB : cB + (size_t)(t + 2) * kstep;
            const char* a3 = a2 + kstep; const char* b3 = b2 + kstep;
            unsigned g2[2][2];
#pragma unroll
            for (int h = 0; h < 2; ++h)
#pragma unroll
                for (int i = 0; i < 2; ++i) g2[h][i] = GATHER ? (last ? gN[h][i] : gC[h][i]) : 0u;
            if constexpr (SP2) {
            PG8_LDB(B0, 0, 0); PG8_LDB(B1, 0, 1); PG8_SCHED; PG8_LDA(At, 0, 0); PG8_STAGE_A(PG8_SA(1, 1), a1, 1, gC);
            PG8_WAIT_V(8); PG8_WAIT_L(0); PG8_BAR;
            if constexpr (Epi::LDS_SCALES) { if (t == 0 && wid == 0) E.prefetch(lds + STAGE_BYTES, cur); }
            PG8_MMA(0, 0, At, B0); PG8_MMA(0, 1, At, B1); PG8_BAR; PG8_SCHED;
            PG8_LDA(At, 0, 1); PG8_STAGE(PG8_SB(0, 0), b2, voffB); PG8_STAGE(PG8_SB(0, 1), b2 + hstepB, voffB); PG8_STAGE_A(PG8_SA(0, 0), a2, 0, g2);
            PG8_WAIT_V(8); PG8_WAIT_L(0); PG8_BAR; PG8_MMA(1, 0, At, B0); PG8_MMA(1, 1, At, B1); PG8_BAR; PG8_SCHED;
            PG8_LDB(B0, 1, 0); PG8_LDB(B1, 1, 1); PG8_SCHED; PG8_LDA(At, 1, 0); PG8_STAGE_A(PG8_SA(0, 1), a2, 1, g2);
            PG8_WAIT_V(8); PG8_WAIT_L(0); PG8_BAR; PG8_MMA(0, 0, At, B0); PG8_MMA(0, 1, At, B1); PG8_BAR; PG8_SCHED;
            PG8_LDA(At, 1, 1); PG8_STAGE(PG8_SB(1, 0), b3, voffB); PG8_STAGE(PG8_SB(1, 1), b3 + hstepB, voffB); PG8_STAGE_A(PG8_SA(1, 0), a3, 0, g2);
            PG8_WAIT_V(8); PG8_WAIT_L(0); PG8_BAR; PG8_MMA(1, 0, At, B0); PG8_MMA(1, 1, At, B1); PG8_BAR; PG8_SCHED;
            } else {
            PG8_LDB(B0, 0, 0); PG8_SCHED; PG8_LDA(At, 0, 0); PG8_STAGE_A(PG8_SA(1, 1), a1, 1, gC);
            PG8_WAIT_L(8); PG8_BAR; PG8_WAIT_L(0); PG8_MMA(0, 0, At, B0); PG8_BAR; PG8_SCHED;
            PG8_LDB(B1, 0, 1); PG8_STAGE(PG8_SB(0, 0), b2, voffB);
            PG8_BAR; PG8_WAIT_L(0); PG8_MMA(0, 1, At, B1); PG8_BAR;
            PG8_LDA(At, 0, 1); PG8_STAGE_A(PG8_SA(0, 0), a2, 0, g2);
            PG8_BAR; PG8_WAIT_L(0); PG8_MMA(1, 0, At, B0); PG8_BAR; PG8_SCHED;
            PG8_STAGE(PG8_SB(0, 1), b2 + hstepB, voffB);
            PG8_WAIT_V(6); PG8_BAR; PG8_MMA(1, 1, At, B1); PG8_BAR;
            PG8_LDB(B0, 1, 0); PG8_SCHED; PG8_LDA(At, 1, 0); PG8_STAGE_A(PG8_SA(0, 1), a2, 1, g2);
            PG8_WAIT_L(8); PG8_BAR; PG8_WAIT_L(0); PG8_MMA(0, 0, At, B0); PG8_BAR; PG8_SCHED;
            PG8_LDB(B1, 1, 1); PG8_STAGE(PG8_SB(1, 0), b3, voffB);
            PG8_BAR; PG8_WAIT_L(0); PG8_MMA(0, 1, At, B1); PG8_BAR;
            PG8_LDA(At, 1, 1); PG8_STAGE_A(PG8_SA(1, 0), a3, 0, g2);
            PG8_BAR; PG8_WAIT_L(0); PG8_MMA(1, 0, At, B0); PG8_BAR; PG8_SCHED;
            PG8_STAGE(PG8_SB(1, 1), b3 + hstepB, voffB);
            PG8_WAIT_V(6); PG8_BAR; PG8_MMA(1, 1, At, B1); PG8_BAR;
            }
        }
        if constexpr (ALIGN_EPI) { if (wr == 0) PG8_BAR; }
        if constexpr (Epi::LDS_SCALES) E(acc, cur, wr, wc, fr, fq, lds + STAGE_BYTES); else E(acc, cur, wr, wc, fr, fq);
#ifdef EPI_TWICE
        if constexpr (Epi::LDS_SCALES) { asm volatile("" ::: "memory"); E(acc, cur, wr, wc, fr, fq, lds + STAGE_BYTES); }
#endif
        if (!has_next) break;
#pragma unroll
        for (int a = 0; a < 2; ++a)
#pragma unroll
            for (int b = 0; b < 2; ++b)
#pragma unroll
                for (int m = 0; m < 4; ++m)
#pragma unroll
                    for (int n = 0; n < 2; ++n) acc[a][b][m][n] = AccT{};
        cur = nxt; cA = nA; cB = nB; ++ui;
        if constexpr (GATHER) {
#pragma unroll
            for (int h = 0; h < 2; ++h)
#pragma unroll
                for (int i = 0; i < 2; ++i) gC[h][i] = gN[h][i]; }
        if constexpr (ALIGN_EPI) { if (wr == 1) PG8_BAR; }
    }
    PG8_WAIT_V(0);
    if constexpr (!ALIGN_EPI) { if (wr == 0) PG8_BAR; }
    PG8_BAR;
#undef PG8_SA
#undef PG8_SB
#undef PG8_STAGE
#undef PG8_STAGE_A
#undef PG8_LDA
#undef PG8_LDB
#undef PG8_MMA
#undef PG8_WAIT_V
#undef PG8_WAIT_L
#undef PG8_BAR
#undef PG8_SCHED
}
}

struct Params { const float* in[N_IN]; float* out; unsigned char* ws; int ph_lo, ph_hi; };

struct Ctx {
    const float* const* in; float* out; unsigned char* ws;
    int tid, lane, wave, G, bid;
    LAS unsigned char* lds;
    __device__ __forceinline__ unsigned* ctl() const { return (unsigned*)(ws + WS_CTL); }
    __device__ __forceinline__ const float* mod(int l) const { return (const float*)(ws + WS_MOD) + (size_t)l * 17 * 6144; }
    __device__ __forceinline__ bf16_t* H() const { return (bf16_t*)(ws + WS_H); }
    __device__ __forceinline__ signed char* H8() const { return (signed char*)(ws + WS_H); }
    __device__ __forceinline__ float* HS() const { return (float*)(ws + WS_HS); }
    __device__ __forceinline__ float* wsc(size_t off) const { return (float*)(ws + WS_WSC + off); }
    __device__ __forceinline__ bf16_t* ZIN() const { return (bf16_t*)(ws + WS_BIG + BG_ZIN); }
    __device__ __forceinline__ bf16_t* Q() const { return (bf16_t*)(ws + WS_BIG + BG_Q); }
    __device__ __forceinline__ bf16_t* KV() const { return (bf16_t*)(ws + WS_BIG + BG_KV); }
    __device__ __forceinline__ bf16_t* MIX() const { return (bf16_t*)(ws + WS_BIG + BG_MIX); }
    __device__ __forceinline__ bf16_t* HMID() const { return (bf16_t*)(ws + WS_BIG + BG_HMID); }
    __device__ __forceinline__ bf16_t* YPAD() const { return (bf16_t*)(ws + WS_BIG + BG_YPAD); }
    __device__ __forceinline__ bf16_t* XB() const { return (bf16_t*)(ws + WS_XB); }
    __device__ __forceinline__ unsigned char* K8() const { return ws + WS_K8; }
    __device__ __forceinline__ unsigned char* R8() const { return ws + WS_R8; }
    __device__ __forceinline__ unsigned char* VT8() const { return ws + WS_VT8; }
    __device__ __forceinline__ float* SSP() const { return (float*)(ws + WS_SSP); }
    __device__ __forceinline__ const float* ROPE() const { return (const float*)(ws + WS_ROPE); }
    __device__ __forceinline__ bf16_t* wsm(int l, size_t off) const { return (bf16_t*)(ws + WS_WSM + (size_t)l * SM_BYTES + off); }
    __device__ __forceinline__ bf16_t* wffn(int i, size_t off) const { return (bf16_t*)(ws + WS_FFN + (size_t)i * FF_BYTES + off); }
    __device__ __forceinline__ bf16_t* wmoe(size_t off) const { return (bf16_t*)(ws + WS_MOE + off); }
};

__device__ __forceinline__ void rope8(f32x4& v0, f32x4& v1, const float* rope, int t, int fq) {
    const int pos = (fq < 2) ? (t >> 6) : (t & 63);
    const f32x4* tb = (const f32x4*)(rope + (size_t)pos * 16 + (fq & 1) * 8);
    const f32x4 c0 = tb[0], c1 = tb[1];
    f32x4 o0, o1;
    o0[0] = v0[0] * c0[0] - v0[1] * c0[1]; o0[1] = v0[0] * c0[1] + v0[1] * c0[0];
    o0[2] = v0[2] * c0[2] - v0[3] * c0[3]; o0[3] = v0[2] * c0[3] + v0[3] * c0[2];
    o1[0] = v1[0] * c1[0] - v1[1] * c1[1]; o1[1] = v1[0] * c1[1] + v1[1] * c1[0];
    o1[2] = v1[2] * c1[2] - v1[3] * c1[3]; o1[3] = v1[2] * c1[3] + v1[3] * c1[2];
    v0 = o0; v1 = o1;
}
constexpr float HID_SCALE = 16.0f;
__device__ __forceinline__ u32x2 pack8_fp8(const f32x4& v0, const f32x4& v1) {
    f32x4 a = v0 * HID_SCALE, b = v1 * HID_SCALE;
#pragma unroll
    for (int j = 0; j < 4; ++j) { a[j] = fminf(fmaxf(a[j], -448.f), 448.f); b[j] = fminf(fmaxf(b[j], -448.f), 448.f); }
    int w0 = __builtin_amdgcn_cvt_pk_fp8_f32(a[0], a[1], 0, false); w0 = __builtin_amdgcn_cvt_pk_fp8_f32(a[2], a[3], w0, true);
    int w1 = __builtin_amdgcn_cvt_pk_fp8_f32(b[0], b[1], 0, false); w1 = __builtin_amdgcn_cvt_pk_fp8_f32(b[2], b[3], w1, true);
    return (u32x2){(unsigned)w0, (unsigned)w1};
}
constexpr float QKSC = 0.3837244402248873f;
__device__ __forceinline__ u32x2 pack8_f8s(const f32x4& v0, const f32x4& v1, float sc) {
    int w0 = __builtin_amdgcn_cvt_pk_fp8_f32(v0[0] * sc, v0[1] * sc, 0, false); w0 = __builtin_amdgcn_cvt_pk_fp8_f32(v0[2] * sc, v0[3] * sc, w0, true);
    int w1 = __builtin_amdgcn_cvt_pk_fp8_f32(v1[0] * sc, v1[1] * sc, 0, false); w1 = __builtin_amdgcn_cvt_pk_fp8_f32(v1[2] * sc, v1[3] * sc, w1, true);
    return (u32x2){(unsigned)w0, (unsigned)w1};
}
__device__ __forceinline__ u32x4 pack8(const f32x4& v0, const f32x4& v1) {
    u32x4 w; w.x = cvt_pk_bf16(v0[0], v0[1]); w.y = cvt_pk_bf16(v0[2], v0[3]); w.z = cvt_pk_bf16(v1[0], v1[1]); w.w = cvt_pk_bf16(v1[2], v1[3]); return w;
}

struct EpiIn {
    static constexpr bool PERM = true, LDS_SCALES = true; using AccT = i32x4;
    bf16_t* Z; float* ssp; const float* rope; const float* hs; const float* wscale; unsigned char* kr8;
    __device__ __forceinline__ void prefetch(LAS unsigned char* scr, const pg8::Unit& u) const {
        const int lane = (int)__builtin_amdgcn_mbcnt_hi(~0u, __builtin_amdgcn_mbcnt_lo(~0u, 0u));
        __builtin_amdgcn_global_load_lds((const unsigned*)(hs + (size_t)u.pm * 256 + 4 * lane), (LAS unsigned*)scr, 16, 0, 0);
        __builtin_amdgcn_global_load_lds((const unsigned*)(wscale + (size_t)u.pn * 256 + 4 * lane), (LAS unsigned*)(scr + 1024), 16, 0, 0);
    }
    __device__ __forceinline__ void operator()(const i32x4 (&acc)[2][2][4][2], const pg8::Unit& u, int wr, int wc, int fr, int fq, const LAS unsigned char* scr) const {
        const int row0 = u.pm * 256 + wr * 64 + fr, pn = u.pn;
        f32x4 cs[2][2];
#pragma unroll
        for (int bj = 0; bj < 2; ++bj) { const LAS float* wp = (const LAS float*)(scr + 1024) + bj * 128 + wc * 32 + 8 * fq; cs[bj][0] = *(const LAS f32x4*)wp; cs[bj][1] = *(const LAS f32x4*)(wp + 4); }
#pragma unroll
        for (int ai = 0; ai < 2; ++ai)
#pragma unroll
            for (int m = 0; m < 4; ++m) {
                const int row = row0 + ai * 128 + m * 16;
                bf16_t* rowp = Z + (size_t)row * ZP + pn * 256 + wc * 32 + 8 * fq; const float rs = ((const LAS float*)scr)[wr * 64 + fr + ai * 128 + m * 16];
                float ss[2];
#pragma unroll
                for (int bj = 0; bj < 2; ++bj) {
                    f32x4 v0 = __builtin_convertvector(acc[ai][bj][m][0], f32x4) * cs[bj][0] * rs, v1 = __builtin_convertvector(acc[ai][bj][m][1], f32x4) * cs[bj][1] * rs;
                    ss[bj] = (v0[0] * v0[0] + v0[1] * v0[1]) + (v0[2] * v0[2] + v0[3] * v0[3]) + (v1[0] * v1[0] + v1[1] * v1[1]) + (v1[2] * v1[2] + v1[3] * v1[3]);
                    if (pn < 3) {
                        const f32x4 z0 = (v0 * -2.302208198144325f) * (1.0f + 0.044715f * (v0 * v0)), z1 = (v1 * -2.302208198144325f) * (1.0f + 0.044715f * (v1 * v1));
                        f32x4 e0, e1;
#pragma unroll
                        for (int j = 0; j < 4; ++j) { e0[j] = fast_exp2(z0[j]); e1[j] = fast_exp2(z1[j]); }
                        const f32x4 d0 = e0 + 1.0f, d1 = e1 + 1.0f;
#pragma unroll
                        for (int j = 0; j < 4; ++j) { e0[j] = fast_rcp(d0[j]); e1[j] = fast_rcp(d1[j]); }
                        v0 = v0 * e0; v1 = v1 * e1;
                    }
                    if (pn == 6 && bj == 1 && wc == 0) { if (row < NLAT) rope8(v0, v1, rope, row & (SEQ - 1), fq);
                        *(u32x2*)(kr8 + (size_t)row * 32 + 8 * fq) = pack8_f8s(v0, v1, QKSC); }
                    if (!(pn == 6 && bj == 1)) *(u32x4*)(rowp + bj * 128) = pack8(v0, v1);
                }
                if (pn >= 4) {
                    float s0 = ss[0], s1 = ss[1];
                    s0 += xor16_f(s0); s0 = sum32_f(s0); s1 += xor16_f(s1); s1 = sum32_f(s1);
                    if (fq == 0) {
                        float* sp = ssp + (size_t)row * 16;
                        if (pn == 4) sp[wc] = s0 + s1;
                        else if (pn == 5) { sp[4 + wc] = s0; sp[8 + wc] = s1; }
                        else sp[12 + wc] = s0;
                    }
                }
            }
    }
};

struct EpiInB {
    static constexpr bool PERM = true, LDS_SCALES = false; using AccT = f32x4;
    bf16_t* Z; float* ssp; const float* rope;
    __device__ __forceinline__ void operator()(const f32x4 (&acc)[2][2][4][2], const pg8::Unit& u, int wr, int wc, int fr, int fq) const {
        const int row0 = u.pm * 256 + wr * 64 + fr, pn = u.pn;
#pragma unroll
        for (int ai = 0; ai < 2; ++ai)
#pragma unroll
            for (int m = 0; m < 4; ++m) {
                const int row = row0 + ai * 128 + m * 16;
                bf16_t* rowp = Z + (size_t)row * ZP + pn * 256 + wc * 32 + 8 * fq;
                float ss[2];
#pragma unroll
                for (int bj = 0; bj < 2; ++bj) {
                    f32x4 v0 = acc[ai][bj][m][0], v1 = acc[ai][bj][m][1];
                    ss[bj] = (v0[0] * v0[0] + v0[1] * v0[1]) + (v0[2] * v0[2] + v0[3] * v0[3]) + (v1[0] * v1[0] + v1[1] * v1[1]) + (v1[2] * v1[2] + v1[3] * v1[3]);
                    if (pn < 3) {
#pragma unroll
                        for (int j = 0; j < 4; ++j) { v0[j] = gelu_tanh_f(v0[j]); v1[j] = gelu_tanh_f(v1[j]); }
                    }
                    if (pn == 6 && bj == 1 && wc == 0 && row < NLAT) rope8(v0, v1, rope, row & (SEQ - 1), fq);
                    *(u32x4*)(rowp + bj * 128) = pack8(v0, v1);
                }
                if (pn >= 4) {
                    float s0 = ss[0], s1 = ss[1];
                    s0 += xor16_f(s0); s0 = sum32_f(s0); s1 += xor16_f(s1); s1 = sum32_f(s1);
                    if (fq == 0) {
                        float* sp = ssp + (size_t)row * 16;
                        if (pn == 4) sp[wc] = s0 + s1;
                        else if (pn == 5) { sp[4 + wc] = s0; sp[8 + wc] = s1; }
                        else sp[12 + wc] = s0;
                    }
                }
            }
    }
};

__device__ __forceinline__ void ssp_prefetch(LAS unsigned char* scr, const float* ssp, int tok0, int slot0) {
    const int lane = (int)__builtin_amdgcn_mbcnt_hi(~0u, __builtin_amdgcn_mbcnt_lo(~0u, 0u));
    const float* gp = ssp + (size_t)(tok0 + (lane >> 1)) * 16 + slot0 + (lane & 1) * 4;
#pragma nounroll
    for (int i = 0; i < 8; ++i)
        __builtin_amdgcn_global_load_lds((const unsigned*)(gp + (size_t)i * 512), (LAS unsigned*)(scr + i * 1024), 16, 0, 0);
}
constexpr float QSCALE = 0.10206207261596577f * 1.4426950408889634f;
struct EpiQ {
    static constexpr bool PERM = true, LDS_SCALES = true; using AccT = f32x4;
    bf16_t* Qo; const float* ssp; const float* rope;
    __device__ __forceinline__ void prefetch(LAS unsigned char* scr, const pg8::Unit& u) const { ssp_prefetch(scr, ssp, u.pm * 256, 0); }
    __device__ __forceinline__ void operator()(const f32x4 (&acc)[2][2][4][2], const pg8::Unit& u, int wr, int wc, int fr, int fq, const LAS unsigned char* scr) const {
        const int row0 = u.pm * 256 + wr * 64 + fr, pn = u.pn;
        float rstd[2][4];
#pragma unroll
        for (int ai = 0; ai < 2; ++ai)
#pragma unroll
            for (int m = 0; m < 4; ++m) {
                const LAS f32x4* sp = (const LAS f32x4*)(scr + (size_t)(wr * 64 + fr + ai * 128 + m * 16) * 32);
                const f32x4 a = sp[0], b = sp[1];
                rstd[ai][m] = __builtin_amdgcn_rsqf(((a[0] + a[1]) + (a[2] + a[3]) + (b[0] + b[1]) + (b[2] + b[3])) * (1.0f / QLORA) + EPS) * QKSC;
            }
#pragma unroll
        for (int ai = 0; ai < 2; ++ai)
#pragma unroll
            for (int m = 0; m < 4; ++m) {
                const int row = row0 + ai * 128 + m * 16;
                unsigned char* rowp = (unsigned char*)Qo + (size_t)row * QP + pn * 256 + wc * 32 + 8 * fq;
#pragma unroll
                for (int bj = 0; bj < 2; ++bj) {
                    f32x4 v0 = acc[ai][bj][m][0] * rstd[ai][m], v1 = acc[ai][bj][m][1] * rstd[ai][m];
                    const int g32 = pn * 8 + bj * 4 + wc;
                    if ((g32 % 3) == 2 && row < NLAT) rope8(v0, v1, rope, row & (SEQ - 1), fq);
                    *(u32x2*)(rowp + bj * 128) = pack8_f8s(v0, v1, 1.0f);
                }
            }
    }
};

struct EpiKV {
    static constexpr bool PERM = true, LDS_SCALES = true; using AccT = f32x4;
    bf16_t* O; const float* ssp; unsigned char* k8;
    __device__ __forceinline__ void prefetch(LAS unsigned char* scr, const pg8::Unit& u) const { ssp_prefetch(scr, ssp, u.pm * 256, 8); }
    __device__ __forceinline__ void operator()(const f32x4 (&acc)[2][2][4][2], const pg8::Unit& u, int wr, int wc, int fr, int fq, const LAS unsigned char* scr) const {
        const int row0 = u.pm * 256 + wr * 64 + fr, pn = u.pn;
        float rstd[2][4];
#pragma unroll
        for (int ai = 0; ai < 2; ++ai)
#pragma unroll
            for (int m = 0; m < 4; ++m) {
                const LAS f32x4* sp = (const LAS f32x4*)(scr + (size_t)(wr * 64 + fr + ai * 128 + m * 16) * 32);
                const f32x4 a = sp[0], b = sp[1];
                rstd[ai][m] = __builtin_amdgcn_rsqf(((a[0] + a[1]) + (a[2] + a[3]) + (b[0] + b[1]) + (b[2] + b[3])) * (1.0f / KVLORA) + EPS);
            }
#pragma unroll
        for (int ai = 0; ai < 2; ++ai)
#pragma unroll
            for (int m = 0; m < 4; ++m) {
                bf16_t* rowp = O + (size_t)(row0 + ai * 128 + m * 16) * KVP + pn * 256 + wc * 32 + 8 * fq;
#pragma unroll
                for (int bj = 0; bj < 2; ++bj) {
                    const f32x4 v0 = acc[ai][bj][m][0] * rstd[ai][m], v1 = acc[ai][bj][m][1] * rstd[ai][m];
                    if (pn < 2) *(u32x2*)(k8 + (size_t)(row0 + ai * 128 + m * 16) * 512 + pn * 256 + bj * 128 + wc * 32 + 8 * fq) = pack8_f8s(v0, v1, QKSC);
                    else *(u32x4*)(rowp + bj * 128) = pack8(v0, v1);
                }
            }
    }
};

struct EpiVT {
    static constexpr bool PERM = true, LDS_SCALES = true; using AccT = f32x4;
    unsigned char* vt8; const float* ssp;
    __device__ __forceinline__ void prefetch(LAS unsigned char* scr, const pg8::Unit& u) const { ssp_prefetch(scr, ssp, u.pn * 256, 8); }
    __device__ __forceinline__ void operator()(const f32x4 (&acc)[2][2][4][2], const pg8::Unit& u, int wr, int wc, int fr, int fq, const LAS unsigned char* scr) const {
        const int dv0 = u.pm * 256 + wr * 64 + fr;
#pragma unroll
        for (int bj = 0; bj < 2; ++bj) {
            const int t0 = u.pn * 256 + bj * 128 + wc * 32 + 8 * fq;
            f32x4 r0, r1;
#pragma unroll
            for (int j = 0; j < 8; ++j) { const LAS f32x4* sp = (const LAS f32x4*)(scr + (size_t)(bj * 128 + wc * 32 + 8 * fq + j) * 32); const f32x4 a = sp[0], b = sp[1];
                const float rs = __builtin_amdgcn_rsqf(((a[0] + a[1]) + (a[2] + a[3]) + (b[0] + b[1]) + (b[2] + b[3])) * (1.0f / KVLORA) + EPS);
                if (j < 4) r0[j & 3] = rs; else r1[j & 3] = rs; }
#pragma unroll
            for (int ai = 0; ai < 2; ++ai)
#pragma unroll
                for (int m = 0; m < 4; ++m)
                    *(u32x2*)(vt8 + ((size_t)(t0 >> 3) * 512 + (dv0 + ai * 128 + m * 16)) * 8) = pack8_f8s(acc[ai][bj][m][0] * r0, acc[ai][bj][m][1] * r1, 1.0f);
        }
    }
};

struct EpiRes {
    static constexpr bool PERM = true, LDS_SCALES = false; using AccT = f32x4;
    const float* lat32; const float* ctx32; bf16_t* xb; const float* gate;
    const float* cscale;
    __device__ __forceinline__ void operator()(const f32x4 (&acc)[2][2][4][2], const pg8::Unit& u, int wr, int wc, int fr, int fq) const {
        const bool isctx = u.pm >= 256;
        const int bsel = isctx ? 16 : (u.pm >> 4);
        const int row0 = u.pm * 256 + wr * 64 + fr, col0 = u.pn * 256 + wc * 32 + 8 * fq;
        const float* gp = gate + (size_t)bsel * 6144 + col0;
        f32x4 gv[2][2];
#pragma unroll
        for (int bj = 0; bj < 2; ++bj)
#pragma unroll
            for (int n = 0; n < 2; ++n) { gv[bj][n] = *(const f32x4*)(gp + bj * 128 + n * 4); if (cscale) gv[bj][n] = gv[bj][n] * *(const f32x4*)(cscale + col0 + bj * 128 + n * 4); }
        const float* s32 = lat32 ? (isctx ? ctx32 + (size_t)(row0 - NLAT) * DM : lat32 + (size_t)row0 * DM) + col0 : nullptr;
#pragma unroll
        for (int ai = 0; ai < 2; ++ai) {
            bf16_t* xp0 = xb + (size_t)row0 * DM + col0 + (size_t)(ai * 128) * DM;
            if (s32) {
                f32x4 sf[4][2][2];
#pragma unroll
                for (int m = 0; m < 4; ++m)
#pragma unroll
                    for (int bj = 0; bj < 2; ++bj) { const float* sp = s32 + (size_t)(ai * 128 + m * 16) * DM + bj * 128; sf[m][bj][0] = *(const f32x4*)sp; sf[m][bj][1] = *(const f32x4*)(sp + 4); }
#pragma unroll
                for (int m = 0; m < 4; ++m)
#pragma unroll
                    for (int bj = 0; bj < 2; ++bj)
                        *(u32x4*)(xp0 + (size_t)(m * 16) * DM + bj * 128) = pack8(sf[m][bj][0] + gv[bj][0] * acc[ai][bj][m][0], sf[m][bj][1] + gv[bj][1] * acc[ai][bj][m][1]);
            } else {
                u32x4 sb[4][2];
#pragma unroll
                for (int m = 0; m < 4; ++m)
#pragma unroll
                    for (int bj = 0; bj < 2; ++bj) sb[m][bj] = *(const u32x4*)(xp0 + (size_t)(m * 16) * DM + bj * 128);
#pragma unroll
                for (int m = 0; m < 4; ++m)
#pragma unroll
                    for (int bj = 0; bj < 2; ++bj) { const u32x4 r = sb[m][bj]; f32x4 s0, s1;
                        s0[0] = __uint_as_float(r[0] << 16); s0[1] = __uint_as_float(r[0] & 0xffff0000u); s0[2] = __uint_as_float(r[1] << 16); s0[3] = __uint_as_float(r[1] & 0xffff0000u);
                        s1[0] = __uint_as_float(r[2] << 16); s1[1] = __uint_as_float(r[2] & 0xffff0000u); s1[2] = __uint_as_float(r[3] << 16); s1[3] = __uint_as_float(r[3] & 0xffff0000u);
                        *(u32x4*)(xp0 + (size_t)(m * 16) * DM + bj * 128) = pack8(s0 + gv[bj][0] * acc[ai][bj][m][0], s1 + gv[bj][1] * acc[ai][bj][m][1]); }
            }
        }
    }
};

struct EpiGlu {
    static constexpr bool PERM = true, LDS_SCALES = true; using AccT = i32x4;
    bf16_t* O; int ld; const float* hs; const float* wscale; const int* list; const float* rscale; const LAS int* tab; int pm0, nN;
    __device__ __forceinline__ void prefetch(LAS unsigned char* scr, const pg8::Unit& u) const {
        const float* rp;
        if (list) { const int e = u.bn / nN, tpe = __builtin_amdgcn_readfirstlane(tab[e]); rp = rscale + (size_t)e * NTOK + (size_t)(pm0 + u.pm - tpe) * 256; }
        else rp = hs + (size_t)u.pm * 256;
        const int lane = (int)__builtin_amdgcn_mbcnt_hi(~0u, __builtin_amdgcn_mbcnt_lo(~0u, 0u));
        __builtin_amdgcn_global_load_lds((const unsigned*)(rp + 4 * lane), (LAS unsigned*)scr, 16, 0, 0);
        __builtin_amdgcn_global_load_lds((const unsigned*)(wscale + (size_t)u.bn * 256 + 4 * lane), (LAS unsigned*)(scr + 1024), 16, 0, 0);
    }
    __device__ __forceinline__ void operator()(const i32x4 (&acc)[2][2][4][2], const pg8::Unit& u, int wr, int wc, int fr, int fq, const LAS unsigned char* scr) const {
        const int row0 = u.pm * 256 + wr * 64 + fr;
        f32x4 cs[2][2];
#pragma unroll
        for (int bj = 0; bj < 2; ++bj) { const LAS float* wp = (const LAS float*)(scr + 1024) + bj * 128 + wc * 32 + 8 * fq; cs[bj][0] = *(const LAS f32x4*)wp; cs[bj][1] = *(const LAS f32x4*)(wp + 4); }
        float rsc[2][4];
#pragma unroll
        for (int ai = 0; ai < 2; ++ai)
#pragma unroll
            for (int m = 0; m < 4; ++m) rsc[ai][m] = ((const LAS float*)scr)[wr * 64 + fr + ai * 128 + m * 16];
#pragma unroll
        for (int ai = 0; ai < 2; ++ai)
#pragma unroll
            for (int m = 0; m < 4; ++m) {
                bf16_t* rowp = O + (size_t)(row0 + ai * 128 + m * 16) * ld + u.pn * 128 + wc * 32 + 8 * fq; const float rs = rsc[ai][m];
                const f32x4 a0 = __builtin_convertvector(acc[ai][0][m][0], f32x4) * cs[0][0] * rs, g0 = __builtin_convertvector(acc[ai][1][m][0], f32x4) * cs[1][0] * rs;
                const f32x4 a1 = __builtin_convertvector(acc[ai][0][m][1], f32x4) * cs[0][1] * rs, g1 = __builtin_convertvector(acc[ai][1][m][1], f32x4) * cs[1][1] * rs;
                const f32x4 z0 = a0 * -1.4426950408889634f, z1 = a1 * -1.4426950408889634f;
                f32x4 e0, e1;
#pragma unroll
                for (int j = 0; j < 4; ++j) { e0[j] = fast_exp2(z0[j]); e1[j] = fast_exp2(z1[j]); }
                const f32x4 d0 = e0 + 1.0f, d1 = e1 + 1.0f;
                f32x4 r0, r1;
#pragma unroll
                for (int j = 0; j < 4; ++j) { r0[j] = fast_rcp(d0[j]); r1[j] = fast_rcp(d1[j]); }
                const f32x4 v0 = (a0 * g0) * r0, v1 = (a1 * g1) * r1;
                if constexpr (DOWN_FP8) {
                    unsigned char* bp = (unsigned char*)O + (size_t)(row0 + ai * 128 + m * 16) * ld + u.pn * 128 + wc * 32 + 8 * fq;
                    *(u32x2*)bp = pack8_fp8(v0, v1);
                } else *(u32x4*)rowp = pack8(v0, v1);
            }
    }
};

struct EpiBf {
    static constexpr bool PERM = true, LDS_SCALES = false; using AccT = f32x4;
    bf16_t* O; int ld; int row_tile0; const float* cscale; int nN;
    __device__ __forceinline__ void operator()(const f32x4 (&acc)[2][2][4][2], const pg8::Unit& u, int wr, int wc, int fr, int fq) const {
        const int row0 = (u.pm + row_tile0) * 256 + wr * 64 + fr;
        f32x4 cs[2][2];
#pragma unroll
        for (int bj = 0; bj < 2; ++bj) { if (cscale) { const float* wp = cscale + (size_t)u.bn * 256 + bj * 128 + wc * 32 + 8 * fq; cs[bj][0] = *(const f32x4*)wp; cs[bj][1] = *(const f32x4*)(wp + 4); } else { cs[bj][0] = (f32x4){1.f, 1.f, 1.f, 1.f}; cs[bj][1] = cs[bj][0]; } }
#pragma unroll
        for (int ai = 0; ai < 2; ++ai)
#pragma unroll
            for (int m = 0; m < 4; ++m) {
                bf16_t* rowp = O + (size_t)(row0 + ai * 128 + m * 16) * ld + u.pn * 256 + wc * 32 + 8 * fq;
#pragma unroll
                for (int bj = 0; bj < 2; ++bj) *(u32x4*)(rowp + bj * 128) = pack8(acc[ai][bj][m][0] * cs[bj][0], acc[ai][bj][m][1] * cs[bj][1]);
            }
    }
};

struct MoeOrder {
    pg8::StaticOrder base; int pm0, nN; const LAS int* tab; const int* list;
    __device__ __forceinline__ int expert_of(int gpm) const { int e = 0;
#pragma unroll
        for (int j = 1; j < NE; ++j) e += (gpm >= tab[j]) ? 1 : 0;
        return __builtin_amdgcn_readfirstlane(e); }
    __device__ __forceinline__ bool next(int i, pg8::Unit& u) const {
        if (!base.next(i, u)) return false;
        u.bn = expert_of(pm0 + u.pm) * nN + u.pn; return true;
    }
    __device__ __forceinline__ void gather(const pg8::Unit& u, int R0, int R1, unsigned (&o)[2][2]) const {
        const int gpm = pm0 + u.pm, e = expert_of(gpm);
        const int tpe = __builtin_amdgcn_readfirstlane(tab[e]), ce = __builtin_amdgcn_readfirstlane(tab[16 + e]);
        const int base_pos = (gpm - tpe) * 256;
#pragma unroll
        for (int h = 0; h < 2; ++h) {
            const int p0 = base_pos + h * 128 + R0, p1 = base_pos + h * 128 + R1;
            o[h][0] = (p0 < ce) ? (unsigned)list[(size_t)e * NTOK + p0] : 0u;
            o[h][1] = (p1 < ce) ? (unsigned)list[(size_t)e * NTOK + p1] : 0u;
        }
    }
};

template <class Map>
__device__ __forceinline__ void cvt_item(const float* W, int N, bf16_t* WT, int K, LAS float* scr, int item, int lane, const Map& map, const float* kscale) {
    const int nblk = N / 32, kb = item / nblk, nb = item % nblk, k0 = 64 * kb, n0 = 32 * nb;
    { const int c4 = (lane & 7) * 4, kr = lane >> 3;
#pragma unroll
      for (int i = 0; i < 8; ++i) { const int kk = kr + 8 * i; f32x4 v = *(const f32x4*)(W + (size_t)(k0 + kk) * N + n0 + c4); if (kscale) v = v * kscale[k0 + kk];
          scr[kk * 33 + c4] = v[0]; scr[kk * 33 + c4 + 1] = v[1]; scr[kk * 33 + c4 + 2] = v[2]; scr[kk * 33 + c4 + 3] = v[3]; } }
    asm volatile("s_waitcnt lgkmcnt(0)" ::: "memory");
    const int c = lane & 7;
#pragma unroll
    for (int j = 0; j < 4; ++j) { const int n = (lane >> 3) + 8 * j; const LAS float* s = scr + (8 * c) * 33 + n;
        u32x4 o; o.x = cvt_pk_bf16(s[0 * 33], s[1 * 33]); o.y = cvt_pk_bf16(s[2 * 33], s[3 * 33]); o.z = cvt_pk_bf16(s[4 * 33], s[5 * 33]); o.w = cvt_pk_bf16(s[6 * 33], s[7 * 33]);
        *(u32x4*)(WT + (size_t)map(n0 + n) * K + k0 + 8 * c) = o; }
    asm volatile("s_waitcnt lgkmcnt(0)" ::: "memory");
}
template <class Map>
__device__ __forceinline__ void cvt8_item(const float* W, int N, int K, signed char* WT, float* scale, LAS float* scr, int item, int lane, const Map& map) {
    const int n0 = 32 * item, c4 = (lane & 7) * 4, kr = lane >> 3;
    f32x4 mx = {0.f, 0.f, 0.f, 0.f};
#pragma unroll 8
    for (int k = kr; k < K; k += 8) { const f32x4 v = *(const f32x4*)(W + (size_t)k * N + n0 + c4);
        mx[0] = fmaxf(mx[0], fabsf(v[0])); mx[1] = fmaxf(mx[1], fabsf(v[1])); mx[2] = fmaxf(mx[2], fabsf(v[2])); mx[3] = fmaxf(mx[3], fabsf(v[3])); }
    LAS float* invs = scr + 64 * 33;
#pragma unroll
    for (int j = 0; j < 4; ++j) { float m = mx[j]; m = fmaxf(m, DPP_F(m, 0x128)); m = fmaxf(m, xor16_f(m)); m = fmaxf(m, xor32_f(m));
        if (lane < 8) { scale[map(n0 + c4 + j)] = m > 0.f ? m * (1.0f / 127.0f) : 1.0f; invs[c4 + j] = m > 0.f ? 127.0f / m : 0.f; } }
    for (int k0 = 0; k0 < K; k0 += 64) {
#pragma unroll
        for (int i = 0; i < 8; ++i) { const int kk = kr + 8 * i; const f32x4 v = *(const f32x4*)(W + (size_t)(k0 + kk) * N + n0 + c4);
            scr[kk * 33 + c4] = v[0]; scr[kk * 33 + c4 + 1] = v[1]; scr[kk * 33 + c4 + 2] = v[2]; scr[kk * 33 + c4 + 3] = v[3]; }
        asm volatile("s_waitcnt lgkmcnt(0)" ::: "memory");
        const int cq = lane & 3;
#pragma unroll
        for (int j = 0; j < 2; ++j) { const int n = (lane >> 2) + 16 * j; const float iv = invs[n]; const LAS float* s = scr + (16 * cq) * 33 + n;
            u32x4 o;
#pragma unroll
            for (int w = 0; w < 4; ++w) { unsigned pk = 0;
#pragma unroll
                for (int b = 0; b < 4; ++b) { const int q = (int)__builtin_rintf(s[(4 * w + b) * 33] * iv); pk |= ((unsigned)q & 0xffu) << (8 * b); }
                o[w] = pk; }
            *(u32x4*)(WT + (size_t)map(n0 + n) * K + k0 + 16 * cq) = o; }
        asm volatile("s_waitcnt lgkmcnt(0)" ::: "memory");
    }
}
template <class Map>
__device__ __forceinline__ void cvtf8_item(const float* W, int N, int K, unsigned char* WT, float* scale, float oscale, LAS float* scr, int item, int lane, const Map& map) {
    const int n0 = 32 * item, c = lane & 31, kh = lane >> 5;
    float mx = 0.f;
    for (int k = kh; k < K; k += 2) mx = fmaxf(mx, fabsf(W[(size_t)k * N + n0 + c]));
    mx = fmaxf(mx, xor32_f(mx));
    const float sc = mx > 0.f ? mx / (448.0f * oscale) : 1.0f, inv = mx > 0.f ? 448.0f / mx : 0.f;
    LAS float* invs = scr + 64 * 33;
    if (lane < 32) { scale[map(n0 + c)] = sc; invs[c] = inv; }
    for (int k0 = 0; k0 < K; k0 += 64) {
#pragma unroll 8
        for (int i = 0; i < 32; ++i) { const int kk = 2 * i + kh; scr[kk * 33 + c] = W[(size_t)(k0 + kk) * N + n0 + c]; }
        asm volatile("s_waitcnt lgkmcnt(0)" ::: "memory");
        const int cq = lane & 3;
#pragma unroll
        for (int j = 0; j < 2; ++j) { const int n = (lane >> 2) + 16 * j; const float iv = invs[n]; const LAS float* s = scr + (16 * cq) * 33 + n;
            u32x4 o;
#pragma unroll
            for (int w = 0; w < 4; ++w) { int pk = __builtin_amdgcn_cvt_pk_fp8_f32(s[(4 * w) * 33] * iv, s[(4 * w + 1) * 33] * iv, 0, false); pk = __builtin_amdgcn_cvt_pk_fp8_f32(s[(4 * w + 2) * 33] * iv, s[(4 * w + 3) * 33] * iv, pk, true); o[w] = (unsigned)pk; }
            *(u32x4*)(WT + (size_t)map(n0 + n) * K + k0 + 16 * cq) = o; }
        asm volatile("s_waitcnt lgkmcnt(0)" ::: "memory");
    }
}
struct MapId { __device__ __forceinline__ int operator()(int c) const { return c; } };
struct MapOff { int off; __device__ __forceinline__ int operator()(int c) const { return c + off; } };
__device__ __forceinline__ int rope_perm(int p) { const int half = p >> 4, w = p & 15, s = w >> 3, i = w & 7; return half * 16 + 2 * i + s; }
struct MapIn { __device__ __forceinline__ int operator()(int c) const { return c < ZR ? c : ZR + rope_perm(c - ZR); } };
struct MapQ { __device__ __forceinline__ int operator()(int c) const { const int h = c / DQK, e = c % DQK; return e < 64 ? c : h * DQK + 64 + rope_perm(e - 64); } };
struct MapGlu { int second; __device__ __forceinline__ int operator()(int c) const { return (c >> 7) * 256 + second * 128 + (c & 127); } };

struct C8Desc { const float* src; signed char* dst; float* scale; int N, n0, kind, sec; };
__device__ __forceinline__ int c8_map(int kind, int sec, int c) { return kind ? (c < ZR ? c : ZR + rope_perm(c - ZR)) : ((c >> 7) * 256 + sec * 128 + (c & 127)); }
__device__ __forceinline__ int c8_count(int set) { return set ? NE * 2 * (DFE / 32) : DEPTH * (D_IN / 32) + 2 * 2 * (DFF / 32) + NE * 2 * (DFE / 32); }
__device__ __forceinline__ C8Desc c8_decode(const Ctx& F, int set, int it) {
    constexpr int I8IN = D_IN / 32, I8F = DFF / 32, I13 = DFE / 32;
    C8Desc d; d.kind = 0;
    if (set == 0 && it < DEPTH * I8IN) { const int l = it / I8IN, item = it % I8IN;
        d.src = F.in[I_WIN] + (size_t)l * DM * D_IN; d.N = D_IN; d.n0 = 32 * item; d.dst = (signed char*)F.wsm(l, SM_IN); d.scale = F.wsc(WSC_IN) + (size_t)l * ZP; d.kind = 1; d.sec = 0; return d; }
    if (set == 0) it -= DEPTH * I8IN;
    if (set == 0 && it < 2 * 2 * I8F) { const int i = it / (2 * I8F), sec = (it / I8F) & 1, item = it % I8F;
        d.src = (sec ? F.in[I_F3] : F.in[I_F1]) + (size_t)i * DM * DFF; d.N = DFF; d.n0 = 32 * item; d.dst = (signed char*)F.wffn(i, FF_13); d.scale = F.wsc(WSC_FF) + (size_t)i * 2 * DFF; d.sec = sec; return d; }
    if (set == 0) it -= 2 * 2 * I8F;
    { const int mi = set, e = it / (2 * I13), r = it % (2 * I13), sec = r / I13, item = r % I13; const size_t eo = ((size_t)mi * NE + e) * (size_t)DM * DFE;
      d.src = (sec ? F.in[I_M3] : F.in[I_M1]) + eo; d.N = DFE; d.n0 = 32 * item; d.dst = (signed char*)F.wmoe(MO_13) + (size_t)e * 2 * DFE * DM; d.scale = F.wsc(WSC_MO) + (size_t)e * 2 * DFE; d.sec = sec; return d; }
}
__device__ __forceinline__ void c8_load(f32x4 (&v)[16], const C8Desc& d, int tid) {
    const float* s = d.src + (size_t)(16 * (tid >> 3)) * d.N + d.n0 + 4 * (tid & 7);
#pragma unroll
    for (int i = 0; i < 16; ++i) v[i] = *(const f32x4*)(s + (size_t)i * d.N);
}
__device__ __forceinline__ void c8_process(const f32x4 (&v)[16], const C8Desc& d, LAS float* red, int tid, int wave) {
    const int c4 = 4 * (tid & 7), kb = tid >> 3;
    f32x4 mx = {0.f, 0.f, 0.f, 0.f};
#pragma unroll
    for (int i = 0; i < 16; ++i) { mx[0] = fmaxf(mx[0], fabsf(v[i][0])); mx[1] = fmaxf(mx[1], fabsf(v[i][1])); mx[2] = fmaxf(mx[2], fabsf(v[i][2])); mx[3] = fmaxf(mx[3], fabsf(v[i][3])); }
#pragma unroll
    for (int j = 0; j < 4; ++j) { float m = mx[j]; m = fmaxf(m, DPP_F(m, 0x128)); m = fmaxf(m, xor16_f(m)); m = fmaxf(m, xor32_f(m)); mx[j] = m; }
    if ((tid & 63) < 8) *(LAS f32x4*)(red + wave * 32 + c4) = mx;
    __syncthreads();
    f32x4 cm = *(const LAS f32x4*)(red + c4);
#pragma unroll
    for (int w = 1; w < NWAVES; ++w) { const f32x4 o = *(const LAS f32x4*)(red + w * 32 + c4); cm[0] = fmaxf(cm[0], o[0]); cm[1] = fmaxf(cm[1], o[1]); cm[2] = fmaxf(cm[2], o[2]); cm[3] = fmaxf(cm[3], o[3]); }
#pragma unroll
    for (int j = 0; j < 4; ++j) {
        const float m = cm[j], inv = m > 0.f ? 127.0f / m : 0.f; const int orow = c8_map(d.kind, d.sec, d.n0 + c4 + j);
        if (tid < 8) d.scale[orow] = m > 0.f ? m * (1.0f / 127.0f) : 1.0f;
        u32x4 o;
#pragma unroll
        for (int w = 0; w < 4; ++w) { unsigned pk = 0;
#pragma unroll
            for (int b = 0; b < 4; ++b) (void)0;
            { const unsigned f0 = __float_as_uint(__builtin_fmaf(v[4 * w][j], inv, 12582912.0f)), f1 = __float_as_uint(__builtin_fmaf(v[4 * w + 1][j], inv, 12582912.0f));
              const unsigned f2 = __float_as_uint(__builtin_fmaf(v[4 * w + 2][j], inv, 12582912.0f)), f3 = __float_as_uint(__builtin_fmaf(v[4 * w + 3][j], inv, 12582912.0f));
              pk = __builtin_amdgcn_perm(f1, f0, 0x0c0c0400u) | __builtin_amdgcn_perm(f3, f2, 0x04000c0cu); }
            o[w] = pk; }
        *(u32x4*)(d.dst + (size_t)orow * DM + 16 * kb) = o;
    }
}
__device__ __forceinline__ void cvt8_run(const Ctx& F, int set, LAS float* red) {
    const int T = c8_count(set);
    int it = F.bid;
    f32x4 va[16], vb[16];
    if (it < T) c8_load(va, c8_decode(F, set, it), F.tid);
#pragma nounroll
    while (it < T) {
        if (it + F.G < T) c8_load(vb, c8_decode(F, set, it + F.G), F.tid);
        c8_process(va, c8_decode(F, set, it), red, F.tid, F.wave);
        it += F.G; if (it >= T) break;
        if (it + F.G < T) c8_load(va, c8_decode(F, set, it + F.G), F.tid);
        c8_process(vb, c8_decode(F, set, it), red + 256, F.tid, F.wave);
        it += F.G;
    }
    __syncthreads();
}

__device__ __forceinline__ void cvt_moe_weights(const Ctx& F, int mi, LAS float* scr) {
    const int gw = F.bid * NWAVES + F.wave, NGW = F.G * NWAVES;
    constexpr int I13 = DFE / 32, I2 = (DFE / 64) * (DM / 32);
    if (DOWN_FP8) {
        for (int it = gw; it < NE * (DM / 32); it += NGW) { const int e = it / (DM / 32), item = it % (DM / 32); const size_t eo = ((size_t)mi * NE + e) * (size_t)DM * DFE;
            cvtf8_item(F.in[I_M2] + eo, DM, DFE, (unsigned char*)F.wmoe(MO_2) + (size_t)e * DM * DFE, F.wsc(WSC_M2) + (size_t)e * DM, HID_SCALE, scr, item, F.lane, MapId{}); }
    } else
    for (int it = gw; it < NE * I2; it += NGW) {
        const int e = it / I2, r = it % I2; const size_t eo = ((size_t)mi * NE + e) * (size_t)DM * DFE;
        cvt_item(F.in[I_M2] + eo, DM, F.wmoe(MO_2) + (size_t)e * DM * DFE, DFE, scr, r, F.lane, MapId{}, nullptr);
    }
}

__device__ __forceinline__ void phase_prologue(const Ctx& F) {
    LAS float* scr = (LAS float*)(F.lds + F.wave * 16384);
    const int gw = F.bid * NWAVES + F.wave, NGW = F.G * NWAVES, gt = F.bid * NTHR + F.tid, NGT = F.G * NTHR;
    for (int i = gt; i < 64 * 8; i += NGT) { const int pos = i >> 3, f = i & 7; const float inv = powf(10000.0f, -(float)(2 * f) / 16.0f); const float a = (float)pos * inv;
        float* r = (float*)(F.ws + WS_ROPE) + i * 2; r[0] = cosf(a); r[1] = sinf(a); }
    for (int i = gt; i < DEPTH * 2 * 256; i += NGT) { const float lam = F.in[I_LAM][i]; const float sp = (lam > 0.f) ? log1pf(expf(-lam)) : (-lam + log1pf(expf(lam)));
        ((float*)(F.ws + WS_C8))[i] = -8.0f * sp; }
    { constexpr int EB = W_IN_I8 ? 1 : 2;
      for (int i = gt; i < DEPTH * (ZP - D_IN) * DM * EB / 16; i += NGT) { const int l = i / ((ZP - D_IN) * DM * EB / 16), r = i % ((ZP - D_IN) * DM * EB / 16);
        *(u32x4*)((signed char*)F.wsm(l, SM_IN) + (size_t)D_IN * DM * EB + (size_t)r * 16) = (u32x4){0u, 0u, 0u, 0u}; } }
    for (int i = gt; i < DEPTH * (ZP - D_IN); i += NGT) F.wsc(WSC_IN)[(size_t)(i / (ZP - D_IN)) * ZP + D_IN + i % (ZP - D_IN)] = 1.0f;
    for (int i = gt; i < DEPTH * 4 * 128 * 128 / 8; i += NGT) { const int l = i / (4 * 128 * 128 / 8), r = i % (4 * 128 * 128 / 8);
        const f32x4* s = (const f32x4*)(F.in[I_SGUW] + (size_t)l * 4 * 128 * 128 + (size_t)r * 8); *(u32x4*)(F.wsm(l, SM_SGU) + (size_t)r * 8) = pack8(s[0], s[1]); }
    {
        LAS float* cs = (LAS float*)(F.lds + 73728);
        for (int i = F.tid; i < 17 * DM; i += NTHR) { const int b = i >> 10, k = i & 1023; const float c = (b < 16) ? F.in[I_C][b * DM + k] : F.in[I_CCTX][k]; cs[i] = silu_f(c); }
        __syncthreads();
        LAS float* red = (LAS float*)(F.lds);
        for (int unit = F.bid; unit < DEPTH * 48; unit += F.G) {
            const int l = unit / 48, n0 = (unit % 48) * 128;
            const float* W = F.in[I_WMOD] + (size_t)l * DM * 6144 + n0 + 2 * F.lane;
            f32x2 a[17];
#pragma unroll
            for (int b = 0; b < 17; ++b) a[b] = (f32x2){0.f, 0.f};
            const int kbeg = F.wave * 128;
#pragma nounroll
            for (int k0 = kbeg; k0 < kbeg + 128; k0 += 16) {
                f32x2 w[16];
#pragma unroll
                for (int i = 0; i < 16; ++i) w[i] = *(const f32x2*)(W + (size_t)(k0 + i) * 6144);
#pragma unroll
                for (int b = 0; b < 17; ++b) {
                    const LAS f32x4* cp = (const LAS f32x4*)(cs + b * DM + k0);
#pragma unroll
                    for (int q = 0; q < 4; ++q) { const f32x4 c = cp[q];
                        a[b] += w[4 * q] * c[0]; a[b] += w[4 * q + 1] * c[1]; a[b] += w[4 * q + 2] * c[2]; a[b] += w[4 * q + 3] * c[3]; }
                }
            }
            __syncthreads();
#pragma unroll
            for (int b = 0; b < 17; ++b) *(LAS f32x2*)(red + (F.wave * 17 + b) * 128 + 2 * F.lane) = a[b];
            __syncthreads();
            for (int i = F.tid; i < 17 * 128; i += NTHR) { const int b = i >> 7, n = i & 127; float s = 0.f;
#pragma unroll
                for (int w = 0; w < 8; ++w) s += red[(w * 17 + b) * 128 + n];
                ((float*)(F.ws + WS_MOD))[((size_t)l * 17 + b) * 6144 + n0 + n] = s + F.in[I_BMOD][l * 6144 + n0 + n]; }
        }
        __syncthreads();
    }
    {
        constexpr int I_IN_ = (DM / 64) * (D_IN / 32), I_OUT_ = (DM / 64) * (DM / 32), I_UQ_ = (QLORA / 64) * (QP / 32), I_UK_ = (KVLORA / 64) * (512 / 32), I_G_ = 2;
        constexpr int PER_L = I_OUT_ + I_UQ_ + 2 * I_UK_ + 16 * I_G_;
        for (int it = gw; it < DEPTH * PER_L; it += NGW) {
            const int l = it / PER_L; int r = it % PER_L;
            if (r < I_OUT_) { cvt_item(F.in[I_WOUT] + (size_t)l * DM * DM, DM, F.wsm(l, SM_OUT), DM, scr, r, F.lane, MapId{}, nullptr); continue; } r -= I_OUT_;
            if (r < I_UQ_) { cvt_item(F.in[I_WUQ] + (size_t)l * QLORA * QP, QP, F.wsm(l, SM_Q), QLORA, scr, r, F.lane, MapQ{}, F.in[I_QN] + l * QLORA); continue; } r -= I_UQ_;
            if (r < I_UK_) { cvt_item(F.in[I_WUK] + (size_t)l * KVLORA * 512, 512, F.wsm(l, SM_KV), KVLORA, scr, r, F.lane, MapId{}, F.in[I_KVN] + l * KVLORA); continue; } r -= I_UK_;
            if (r < I_UK_) { cvt_item(F.in[I_WUV] + (size_t)l * KVLORA * 512, 512, F.wsm(l, SM_KV), KVLORA, scr, r, F.lane, MapOff{512}, F.in[I_KVN] + l * KVLORA); continue; } r -= I_UK_;
            {
                const int mat = r / I_G_, item = r % I_G_, d = mat >> 3, gate = (mat >> 2) & 1, hh = mat & 3;
                const float* src = (gate ? F.in[I_LWX] : F.in[I_LWA]) + (((size_t)l * 2 + d) * 4 + hh) * 64 * 64;
                cvt_item(src, 64, F.wsm(l, SM_GW) + (size_t)((d * 2 + gate) * 4 + hh) * 64 * 64, 64, scr, item, F.lane, MapId{}, nullptr);
            }
        }
        if (!W_IN_I8) { constexpr int I_INB = (DM / 64) * (D_IN / 32);
            for (int it = gw; it < DEPTH * I_INB; it += NGW) { const int l = it / I_INB, r = it % I_INB; cvt_item(F.in[I_WIN] + (size_t)l * DM * D_IN, D_IN, F.wsm(l, SM_IN), DM, scr, r, F.lane, MapIn{}, nullptr); } }
        constexpr int IF2 = (DFF / 64) * (DM / 32);
        if (DOWN_FP8) { for (int it = gw; it < 2 * (DM / 32); it += NGW) { const int i = it / (DM / 32), item = it % (DM / 32);
                cvtf8_item(F.in[I_F2] + (size_t)i * DFF * DM, DM, DFF, (unsigned char*)F.wffn(i, FF_2), F.wsc(WSC_F2) + (size_t)i * DM, HID_SCALE, scr, item, F.lane, MapId{}); } }
        else
        for (int it = gw; it < 2 * IF2; it += NGW) { const int i = it / IF2, r = it % IF2; cvt_item(F.in[I_F2] + (size_t)i * DFF * DM, DM, F.wffn(i, FF_2), DFF, scr, r, F.lane, MapId{}, nullptr); }
        cvt_moe_weights(F, 0, scr);
        cvt8_run(F, 0, (LAS float*)(F.lds + 135168));
    }
}

__device__ __forceinline__ void moe_table(const Ctx& F, int mi, LAS int* tab) {
    if (F.tid < 64) {
        const unsigned* c = F.ctl() + CW_CNT + mi * NE * 64;
        const int n = (F.tid < NE) ? (int)__hip_atomic_load(c + F.tid * 64, __ATOMIC_RELAXED, __HIP_MEMORY_SCOPE_AGENT) : 0;
        const int t = (n + 255) >> 8;
        int inc = t;
        inc += __builtin_amdgcn_update_dpp(0, inc, 0x111, 0xf, 0xf, true);
        inc += __builtin_amdgcn_update_dpp(0, inc, 0x112, 0xf, 0xf, true);
        inc += __builtin_amdgcn_update_dpp(0, inc, 0x114, 0xf, 0xf, true);
        if (F.tid < NE) { tab[16 + F.tid] = n; tab[F.tid] = inc - t; if (F.tid == NE - 1) tab[NE] = inc; }
    }
    __syncthreads();
}

template <int MODE, bool X32 = false>
__device__ __forceinline__ void phase_norm(const Ctx& F, int l, int nrows, bool combine, int mi_prev) {
    const float* modl = F.mod(l < DEPTH ? l : DEPTH - 1);
    const float* gain = (MODE == 0) ? F.in[I_N1G] + l * DM : (MODE == 3) ? F.in[I_FNG] : F.in[I_N2G] + l * DM;
    const int sh_off = (MODE == 0) ? 0 : 3072, sc_off = (MODE == 0) ? 1024 : 4096;
    LAS int* tab = (LAS int*)(F.lds + 65536);
    if (combine) moe_table(F, mi_prev, tab);
    const float* g2prev = F.mod(MODE == 3 ? DEPTH - 1 : l - 1) + 5120;
    LAS float* wr_t = (LAS float*)F.lds;
    LAS int* lcnt = (LAS int*)(F.lds + 32768);
    LAS int* lrow = (LAS int*)(F.lds + 32768 + 256);
    if (MODE == 2) {
        const float* wr = F.in[I_ROUT] + (size_t)(l >> 1) * DM * NE;
        (void)wr_t; (void)wr;
        if (F.tid < 16) lcnt[F.tid] = 0;
        __syncthreads();
    }
    const int gw = F.bid * NWAVES + F.wave, NGW = F.G * NWAVES;
    const float* xlat = F.in[I_X]; const float* xctx = F.in[I_CTX];
    bf16_t* xb = F.XB();
    int lr = F.wave;
    const bool bmap = (NGW == 2048) && (nrows == NLAT || nrows == NTOK);
    const int steps = bmap ? nrows / 2048 : (nrows - gw + NGW - 1) / NGW;
#define ROWOF(k) (bmap ? ((k) < 32 ? (gw >> 7) * 4096 + (gw & 127) + 128 * (k) : NLAT + gw + 2048 * ((k) - 32)) : gw + (k) * NGW)
    f32x4 g1[4], shv[4]; int cbs = -1;
    f32x4 vnx[4]; u32x2 rnx[4];
    if (0 < steps) { const int r0 = ROWOF(0);
        if constexpr (X32) { const float* xr0 = (r0 >= NLAT) ? xctx + (size_t)(r0 - NLAT) * DM : xlat + (size_t)r0 * DM;
#pragma unroll
            for (int j = 0; j < 4; ++j) vnx[j] = *(const f32x4*)(xr0 + 4 * F.lane + 256 * j); }
        else {
#pragma unroll
            for (int j = 0; j < 4; ++j) rnx[j] = *(const u32x2*)(xb + (size_t)r0 * DM + 4 * F.lane + 256 * j); } }
    float wq[NE][16];
    if (MODE == 2) { const float* wr = F.in[I_ROUT] + (size_t)(l >> 1) * DM * NE;
#pragma unroll
        for (int j = 0; j < 4; ++j)
#pragma unroll
            for (int b = 0; b < 4; ++b) { const int c = 4 * F.lane + 256 * j + b; const f32x4 lo = *(const f32x4*)(wr + (size_t)c * NE), hi4 = *(const f32x4*)(wr + (size_t)c * NE + 4);
                wq[0][4 * j + b] = lo[0]; wq[1][4 * j + b] = lo[1]; wq[2][4 * j + b] = lo[2]; wq[3][4 * j + b] = lo[3];
                wq[4][4 * j + b] = hi4[0]; wq[5][4 * j + b] = hi4[1]; wq[6][4 * j + b] = hi4[2]; wq[7][4 * j + b] = hi4[3]; } }
    u32x2 cya[4], cyb[4]; int4 epn = make_int4(0, 0, 0, 0); f32x2 ggc = {0.f, 0.f}, ggn = {0.f, 0.f};
#define YLOAD(ep_) do { const bf16_t* y0_ = F.YPAD() + ((size_t)tab[(ep_).x] * 256 + (ep_).y) * DM, * y1_ = F.YPAD() + ((size_t)tab[(ep_).z] * 256 + (ep_).w) * DM; \
        _Pragma("unroll") for (int j = 0; j < 4; ++j) { cya[j] = *(const u32x2*)(y0_ + 4 * F.lane + 256 * j); cyb[j] = *(const u32x2*)(y1_ + 4 * F.lane + 256 * j); } } while (0)
    if (combine && 0 < steps) { const int r0 = ROWOF(0); const int4 ep0 = *(const int4*)(F.ws + WS_TOPE + (size_t)r0 * 16); ggc = *(const f32x2*)(F.ws + WS_TOPG + (size_t)r0 * 8);
        if (1 < steps) { const int r1 = ROWOF(1); epn = *(const int4*)(F.ws + WS_TOPE + (size_t)r1 * 16); ggn = *(const f32x2*)(F.ws + WS_TOPG + (size_t)r1 * 8); }
        YLOAD(ep0); }
    for (int k = 0; k < steps; ++k, lr += NWAVES) {
        const int row = ROWOF(k);
        const bool isctx = row >= NLAT; const int bsel = isctx ? 16 : (row >> 12);
        f32x4 v[4];
        if constexpr (X32) {
#pragma unroll
            for (int j = 0; j < 4; ++j) v[j] = vnx[j];
            if (k + 1 < steps) { const int rn = ROWOF(k + 1); const float* xrn = (rn >= NLAT) ? xctx + (size_t)(rn - NLAT) * DM : xlat + (size_t)rn * DM;
#pragma unroll
                for (int j = 0; j < 4; ++j) vnx[j] = *(const f32x4*)(xrn + 4 * F.lane + 256 * j); }
        } else {
#pragma unroll
            for (int j = 0; j < 4; ++j) { v[j][0] = __uint_as_float(rnx[j][0] << 16); v[j][1] = __uint_as_float(rnx[j][0] & 0xffff0000u); v[j][2] = __uint_as_float(rnx[j][1] << 16); v[j][3] = __uint_as_float(rnx[j][1] & 0xffff0000u); }
            if (k + 1 < steps) { const int rn = ROWOF(k + 1);
#pragma unroll
                for (int j = 0; j < 4; ++j) rnx[j] = *(const u32x2*)(xb + (size_t)rn * DM + 4 * F.lane + 256 * j); }
        }
        if (bsel != cbs) { cbs = bsel;
#pragma unroll
            for (int j = 0; j < 4; ++j) { const int c = 4 * F.lane + 256 * j; const f32x4 g = *(const f32x4*)(gain + c);
                if (MODE == 3) { g1[j] = g; shv[j] = (f32x4){0.f, 0.f, 0.f, 0.f}; }
                else { const f32x4 sc = *(const f32x4*)(modl + (size_t)bsel * 6144 + sc_off + c); g1[j] = g * (1.0f + sc); shv[j] = *(const f32x4*)(modl + (size_t)bsel * 6144 + sh_off + c); } } }
        if (combine) {
            const f32x2 gg = ggc;
#pragma unroll
            for (int j = 0; j < 4; ++j) {
                const u32x2 a = cya[j], b = cyb[j];
                const f32x4 g = *(const f32x4*)(g2prev + (size_t)bsel * 6144 + 4 * F.lane + 256 * j);
                f32x4 ya, yb; ya[0] = __uint_as_float(a.x << 16); ya[1] = __uint_as_float(a.x & 0xffff0000u); ya[2] = __uint_as_float(a.y << 16); ya[3] = __uint_as_float(a.y & 0xffff0000u);
                yb[0] = __uint_as_float(b.x << 16); yb[1] = __uint_as_float(b.x & 0xffff0000u); yb[2] = __uint_as_float(b.y << 16); yb[3] = __uint_as_float(b.y & 0xffff0000u);
                v[j] = v[j] + g * (ya * gg[0] + yb * gg[1]);
            }
            if (k + 1 < steps) { YLOAD(epn); ggc = ggn;
                if (k + 2 < steps) { const int r2 = ROWOF(k + 2); epn = *(const int4*)(F.ws + WS_TOPE + (size_t)r2 * 16); ggn = *(const f32x2*)(F.ws + WS_TOPG + (size_t)r2 * 8); } }
            if (MODE != 3) {
#pragma unroll
                for (int j = 0; j < 4; ++j) { u32x2 w; w[0] = cvt_pk_bf16(v[j][0], v[j][1]); w[1] = cvt_pk_bf16(v[j][2], v[j][3]); *(u32x2*)(xb + (size_t)row * DM + 4 * F.lane + 256 * j) = w; } }
        }
        float s = 0.f;
#pragma unroll
        for (int j = 0; j < 4; ++j) s += (v[j][0] * v[j][0] + v[j][1] * v[j][1]) + (v[j][2] * v[j][2] + v[j][3] * v[j][3]);
        const float rstd = 1.0f / sqrtf(wave_sum(s) * (1.0f / DM) + EPS);
        if (MODE == 3) {
#pragma unroll
            for (int j = 0; j < 4; ++j) *(f32x4*)(F.out + (size_t)row * DM + 4 * F.lane + 256 * j) = v[j] * rstd * g1[j];
            continue;
        }
        f32x4 h[4]; float amax = 0.f;
#pragma unroll
        for (int j = 0; j < 4; ++j) {
            h[j] = (v[j] * rstd) * g1[j] + shv[j];
            amax = fmaxf(fmaxf(amax, fmaxf(fabsf(h[j][0]), fabsf(h[j][1]))), fmaxf(fabsf(h[j][2]), fabsf(h[j][3])));
        }
        if (MODE == 0 && !W_IN_I8) {
#pragma unroll
            for (int j = 0; j < 4; ++j) { u32x2 w; w.x = cvt_pk_bf16(h[j][0], h[j][1]); w.y = cvt_pk_bf16(h[j][2], h[j][3]); *(u32x2*)(F.H() + (size_t)row * DM + 4 * F.lane + 256 * j) = w; }
            continue;
        }
        amax = wave_max(amax);
        const float qinv = amax > 0.f ? 127.0f / amax : 0.f;
        if (F.lane == 0) F.HS()[row] = amax > 0.f ? amax * (1.0f / 127.0f) : 1.0f;
#pragma unroll
        for (int j = 0; j < 4; ++j) {
            unsigned pk = 0;
#pragma unroll
            for (int b = 0; b < 4; ++b) (void)0;
            {
                const unsigned f0 = __float_as_uint(__builtin_fmaf(h[j][0], qinv, 12582912.0f)), f1 = __float_as_uint(__builtin_fmaf(h[j][1], qinv, 12582912.0f));
                const unsigned f2 = __float_as_uint(__builtin_fmaf(h[j][2], qinv, 12582912.0f)), f3 = __float_as_uint(__builtin_fmaf(h[j][3], qinv, 12582912.0f));
                pk = __builtin_amdgcn_perm(f1, f0, 0x0c0c0400u) | __builtin_amdgcn_perm(f3, f2, 0x04000c0cu); }
            *(unsigned*)(F.H8() + (size_t)row * DM + 4 * F.lane + 256 * j) = pk;
        }
        if (MODE == 2) {
            float lg[NE];
#pragma unroll
            for (int e = 0; e < NE; ++e) { float a = 0.f;
#pragma unroll
                for (int j = 0; j < 4; ++j) a += (h[j][0] * wq[e][4 * j] + h[j][1] * wq[e][4 * j + 1]) + (h[j][2] * wq[e][4 * j + 2] + h[j][3] * wq[e][4 * j + 3]);
                lg[e] = wave_sum(a); }
            int e0 = 0; float v0 = lg[0];
#pragma unroll
            for (int e = 1; e < NE; ++e) if (lg[e] > v0) { v0 = lg[e]; e0 = e; }
            int e1 = -1; float v1 = -3.0e38f;
#pragma unroll
            for (int e = 0; e < NE; ++e) if (e != e0 && lg[e] > v1) { v1 = lg[e]; e1 = e; }
            const float ex = expf(v1 - v0), g0 = 1.0f / (1.0f + ex), g1 = ex / (1.0f + ex);
            if (F.lane == 0) {
                const int r0 = atomicAdd((int*)&lcnt[e0], 1), r1 = atomicAdd((int*)&lcnt[e1], 1);
                lrow[lr * 4 + 0] = e0; lrow[lr * 4 + 1] = r0; lrow[lr * 4 + 2] = e1; lrow[lr * 4 + 3] = r1;
                *(f32x2*)(F.ws + WS_TOPG + (size_t)row * 8) = (f32x2){g0, g1};
            }
        }
    }
    if (MODE == 2) {
        __syncthreads();
        unsigned* gc = F.ctl() + CW_CNT + (l >> 1) * NE * 64;
        if (F.tid < NE) lcnt[8 + F.tid] = (int)atomicAdd(gc + F.tid * 64, (unsigned)lcnt[F.tid]);
        __syncthreads();
        for (int k0 = 0; k0 < steps; k0 += 64) { const int k = k0 + F.lane;
            if (k < steps) { const int row = ROWOF(k), lr2 = F.wave + NWAVES * k;
                const int e0 = lrow[lr2 * 4 + 0], p0 = lcnt[8 + e0] + lrow[lr2 * 4 + 1], e1 = lrow[lr2 * 4 + 2], p1 = lcnt[8 + e1] + lrow[lr2 * 4 + 3];
                *(int4*)(F.ws + WS_TOPE + (size_t)row * 16) = make_int4(e0, p0, e1, p1);
                int* list = (int*)(F.ws + WS_LIST); float* rsc = (float*)(F.ws + WS_RSC); const float hsr = F.HS()[row];
                list[(size_t)e0 * NTOK + p0] = row; list[(size_t)e1 * NTOK + p1] = row; rsc[(size_t)e0 * NTOK + p0] = hsr; rsc[(size_t)e1 * NTOK + p1] = hsr;
            }
        }
    }
#undef ROWOF
#undef YLOAD
}

__device__ __forceinline__ void phase_sgu(const Ctx& F, int l, int nchunks, int u0, int ustride) {
    constexpr int VP = 136;
    LAS bf16_t* VT = (LAS bf16_t*)F.lds;
    const int lane = F.lane, r32 = lane & 31, hi = lane >> 5, w = F.wave;
    const float* lng = F.in[I_SLNG] + l * 256, * lnb = F.in[I_SLNB] + l * 256;
    const bf16_t* Wb = F.wsm(l, SM_SGU);
    const float* sb = F.in[I_SGUB] + l * 4 * 128;
    const f32x4 g4 = *(const f32x4*)(lng + 4 * lane), b4 = *(const f32x4*)(lnb + 4 * lane);
    bf16x8 wa0[8], wa1[8];
    { const bf16_t* Wh0 = Wb + (size_t)(w >> 1) * 128 * 128 + (size_t)((w & 1) * 64 + r32) * 128 + hi * 8;
#pragma unroll
      for (int ks = 0; ks < 8; ++ks) { wa0[ks] = *(const bf16x8*)(Wh0 + ks * 16); wa1[ks] = *(const bf16x8*)(Wh0 + 32 * 128 + ks * 16); } }
    for (int cu = u0; cu < nchunks; cu += ustride) {
        const int tok0 = cu * 128;
        for (int q = w * 16; q < w * 16 + 16; ++q) {
            const u32x2 raw = *(const u32x2*)(F.ZIN() + (size_t)(tok0 + q) * ZP + ZV + 4 * lane);
            float x0 = __uint_as_float(raw.x << 16), x1 = __uint_as_float(raw.x & 0xffff0000u), x2 = __uint_as_float(raw.y << 16), x3 = __uint_as_float(raw.y & 0xffff0000u);
            const float mean = wave_sum((x0 + x1) + (x2 + x3)) * (1.0f / 256.0f);
            x0 -= mean; x1 -= mean; x2 -= mean; x3 -= mean;
            const float rstd = 1.0f / sqrtf(wave_sum((x0 * x0 + x1 * x1) + (x2 * x2 + x3 * x3)) * (1.0f / 256.0f) + EPS);
            const int qs = q ^ ((lane & 15) << 3);
            VT[(4 * lane + 0) * VP + qs] = f2bf(x0 * rstd * g4[0] + b4[0]); VT[(4 * lane + 1) * VP + qs] = f2bf(x1 * rstd * g4[1] + b4[1]);
            VT[(4 * lane + 2) * VP + qs] = f2bf(x2 * rstd * g4[2] + b4[2]); VT[(4 * lane + 3) * VP + qs] = f2bf(x3 * rstd * g4[3] + b4[3]);
        }
        __syncthreads();
        const int hh = w >> 1, ph = w & 1;
        f32x16 acc[2][2];
#pragma unroll
        for (int a = 0; a < 2; ++a)
#pragma unroll
            for (int b = 0; b < 2; ++b) acc[a][b] = f32x16{};
        const LAS bf16_t* Vh = VT + (hh * 64 + r32) * VP;
        const int sw0 = ((r32 >> 2) & 15) << 3, sw1 = (((r32 >> 2) + 8) & 15) << 3;
#pragma unroll
        for (int ks = 0; ks < 8; ++ks) {
            const bf16x8 a0 = wa0[ks], a1 = wa1[ks];
            const bf16x8 b0 = *(const LAS bf16x8*)(Vh + ((ks * 16 + hi * 8) ^ sw0)), b1 = *(const LAS bf16x8*)(Vh + 32 * VP + ((ks * 16 + hi * 8) ^ sw1));
            acc[0][0] = __builtin_amdgcn_mfma_f32_32x32x16_bf16(b0, a0, acc[0][0], 0, 0, 0);
            acc[0][1] = __builtin_amdgcn_mfma_f32_32x32x16_bf16(b1, a0, acc[0][1], 0, 0, 0);
            acc[1][0] = __builtin_amdgcn_mfma_f32_32x32x16_bf16(b0, a1, acc[1][0], 0, 0, 0);
            acc[1][1] = __builtin_amdgcn_mfma_f32_32x32x16_bf16(b1, a1, acc[1][1], 0, 0, 0);
        }
#pragma unroll
        for (int mb = 0; mb < 2; ++mb) {
            const int pp = ph * 64 + mb * 32 + r32; const float bias = sb[hh * 128 + pp]; const size_t tok = (size_t)(tok0 + pp);
#pragma unroll
            for (int nb = 0; nb < 2; ++nb)
#pragma unroll
                for (int g = 0; g < 4; g += 2) {
                    unsigned x[4], y[4];
#pragma unroll
                    for (int j = 0; j < 4; ++j) { x[j] = __float_as_uint(acc[mb][nb][4 * g + j] + bias); y[j] = __float_as_uint(acc[mb][nb][4 * g + 4 + j] + bias); pl32swap(x[j], y[j]); }
                    const int ch = hh * 64 + nb * 32 + (g + hi) * 8;
                    const u32x4 ur = *(const u32x4*)(F.ZIN() + tok * ZP + ZU + ch);
                    f32x4 v0, v1;
                    v0[0] = __uint_as_float(ur[0] << 16) * __uint_as_float(x[0]); v0[1] = __uint_as_float(ur[0] & 0xffff0000u) * __uint_as_float(x[1]);
                    v0[2] = __uint_as_float(ur[1] << 16) * __uint_as_float(x[2]); v0[3] = __uint_as_float(ur[1] & 0xffff0000u) * __uint_as_float(x[3]);
                    v1[0] = __uint_as_float(ur[2] << 16) * __uint_as_float(y[0]); v1[1] = __uint_as_float(ur[2] & 0xffff0000u) * __uint_as_float(y[1]);
                    v1[2] = __uint_as_float(ur[3] << 16) * __uint_as_float(y[2]); v1[3] = __uint_as_float(ur[3] & 0xffff0000u) * __uint_as_float(y[3]);
                    *(u32x4*)(F.MIX() + tok * DM + ch) = pack8(v0, v1);
                }
        }
        __syncthreads();
    }
}

__device__ __forceinline__ float neg_expm1(float z) {
    if (z > -0.25f) { return -z * (1.0f + z * (0.5f + z * ((1.0f / 6.0f) + z * ((1.0f / 24.0f) + z * ((1.0f / 120.0f) + z * (1.0f / 720.0f)))))); }
    return 1.0f - fast_exp2(1.4426950408889634f * z);
}

template <int PASS, int DIR>
__device__ __forceinline__ void lru_scan(const float (&av)[16], const float (&bv)[16], int hi, float (&hout)[16], unsigned char* ws, size_t idx) {
    float GA[4], GB[4], PA[4], PB[4];
#pragma unroll
    for (int g = 0; g < 4; ++g) { float A = 1.f, B = 0.f;
#pragma unroll
        for (int ii = 0; ii < 4; ++ii) { constexpr int dummy = 0; const int i = DIR ? 3 - ii : ii; A = A * av[4 * g + i]; B = B * av[4 * g + i] + bv[4 * g + i]; (void)dummy; }
        GA[g] = A; GB[g] = B; PA[g] = xor32_f(A); PB[g] = xor32_f(B); }
    const bool first = DIR ? (hi == 1) : (hi == 0);
    if (PASS == 1) {
        float A = 1.f, B = 0.f;
#pragma unroll
        for (int gg = 0; gg < 4; ++gg) { const int g = DIR ? 3 - gg : gg;
            const float A1 = first ? GA[g] : PA[g], B1 = first ? GB[g] : PB[g], A2 = first ? PA[g] : GA[g], B2 = first ? PB[g] : GB[g];
            B = B * A1 + B1; A = A * A1; B = B * A2 + B2; A = A * A2; }
        if (hi == 0) *(f32x2*)(ws + WS_AGG + idx * 8) = (f32x2){A, B};
    } else {
        float h = ((const float*)(ws + WS_CARRY))[idx];
#pragma unroll
        for (int gg = 0; gg < 4; ++gg) { const int g = DIR ? 3 - gg : gg;
            const float A1 = first ? GA[g] : PA[g], B1 = first ? GB[g] : PB[g], A2 = first ? PA[g] : GA[g], B2 = first ? PB[g] : GB[g];
            const float hmid = h * A1 + B1;
            float hc = first ? h : hmid;
            h = hmid * A2 + B2;
#pragma unroll
            for (int ii = 0; ii < 4; ++ii) { const int i = DIR ? 3 - ii : ii; hc = hc * av[4 * g + i] + bv[4 * g + i]; hout[4 * g + i] = hc; }
        }
    }
}
template <int PASS>
__device__ __forceinline__ void phase_lru(const Ctx& F, int l, int nseg_total, int u0, int ustride) {
    constexpr int XCP = 264;
    LAS float* XB = (LAS float*)F.lds;
    LAS float* XCF = (LAS float*)(F.lds + 36864);
    LAS bf16_t* XC = (LAS bf16_t*)(F.lds + 36864 + 32768);
    const int tid = F.tid, lane = F.lane, r32 = lane & 31, hi = lane >> 5, w = F.wave, hh = w >> 1, dir = w & 1;
    const float* cw = F.in[I_CONVW] + l * 4 * 256, * cb = F.in[I_CONVB] + l * 256;
    const bf16_t* GW = F.wsm(l, SM_GW);
    const float* c8p = (const float*)(F.ws + WS_C8) + (l * 2 + dir) * 256;
    const float* bap = F.in[I_LBA] + (l * 2 + dir) * 256, * bxp = F.in[I_LBX] + (l * 2 + dir) * 256;
    for (int sg = u0; sg < nseg_total; sg += ustride) {
        const int r0 = sg * 32;
        int seq0, slen, b, sidx;
        if (r0 < NLAT) { b = r0 >> 12; seq0 = b << 12; slen = SEQ; sidx = 8 + ((r0 - seq0) >> 5); }
        else { b = (r0 - NLAT) >> 8; seq0 = NLAT + (b << 8); slen = LC; sidx = (r0 - seq0) >> 5; }
        for (int i = tid; i < 35 * 32; i += NTHR) {
            const int rr = i >> 5, c8 = (i & 31) * 8; const int row = r0 - 2 + rr;
            f32x4 lo = {0.f, 0.f, 0.f, 0.f}, hi4 = {0.f, 0.f, 0.f, 0.f};
            if (row >= seq0 && row < seq0 + slen) { const u32x4 raw = *(const u32x4*)(F.ZIN() + (size_t)row * ZP + ZX + c8);
                lo[0] = __uint_as_float(raw.x << 16); lo[1] = __uint_as_float(raw.x & 0xffff0000u); lo[2] = __uint_as_float(raw.y << 16); lo[3] = __uint_as_float(raw.y & 0xffff0000u);
                hi4[0] = __uint_as_float(raw.z << 16); hi4[1] = __uint_as_float(raw.z & 0xffff0000u); hi4[2] = __uint_as_float(raw.w << 16); hi4[3] = __uint_as_float(raw.w & 0xffff0000u); }
            *(LAS f32x4*)(XB + rr * 256 + c8) = lo; *(LAS f32x4*)(XB + rr * 256 + c8 + 4) = hi4;
        }
        __syncthreads();
        {
            const int t = tid >> 4, c0 = (tid & 15) * 16;
#pragma unroll
            for (int q = 0; q < 4; ++q) {
                const int c = c0 + 4 * q;
                f32x4 a = *(const f32x4*)(cb + c);
#pragma unroll
                for (int j = 0; j < 4; ++j) a = a + *(const f32x4*)(cw + j * 256 + c) * *(const LAS f32x4*)(XB + (t + j) * 256 + c);
                *(LAS f32x4*)(XCF + t * 256 + c) = a;
                u32x2 pk; pk.x = cvt_pk_bf16(a[0], a[1]); pk.y = cvt_pk_bf16(a[2], a[3]);
                *(LAS u32x2*)(XC + t * XCP + c) = pk;
            }
        }
        __syncthreads();
        f32x16 acc[2][2];
#pragma unroll
        for (int a = 0; a < 2; ++a)
#pragma unroll
            for (int jb = 0; jb < 2; ++jb) acc[a][jb] = f32x16{};
#pragma unroll
        for (int ks = 0; ks < 4; ++ks) {
            const bf16x8 af = *(const LAS bf16x8*)(XC + r32 * XCP + hh * 64 + ks * 16 + hi * 8);
#pragma unroll
            for (int gt = 0; gt < 2; ++gt)
#pragma unroll
                for (int jb = 0; jb < 2; ++jb) {
                    const bf16x8 bfr = *(const bf16x8*)(GW + (size_t)((dir * 2 + gt) * 4 + hh) * 4096 + (size_t)(jb * 32 + r32) * 64 + ks * 16 + hi * 8);
                    acc[gt][jb] = __builtin_amdgcn_mfma_f32_32x32x16_bf16(af, bfr, acc[gt][jb], 0, 0, 0);
                }
        }
        float hout[2][16];
#pragma unroll
        for (int jb = 0; jb < 2; ++jb) {
            const int ch = hh * 64 + jb * 32 + r32;
            const float ba = bap[ch], bx = bxp[ch], c8 = c8p[ch];
            float av[16], bv[16];
#pragma unroll
            for (int r = 0; r < 16; ++r) {
                const int t = crow(r, hi);
                const float ra = sigmoid_f(acc[0][jb][r] + ba), ix = sigmoid_f(acc[1][jb][r] + bx);
                const float la = c8 * ra;
                av[r] = fast_exp2(1.4426950408889634f * la);
                bv[r] = sqrtf(neg_expm1(2.0f * la)) * (ix * XCF[t * 256 + ch]);
            }
            if (dir) lru_scan<PASS, 1>(av, bv, hi, hout[jb], F.ws, (((size_t)b * NSEG + sidx) * 2 + 1) * 256 + ch);
            else     lru_scan<PASS, 0>(av, bv, hi, hout[jb], F.ws, (((size_t)b * NSEG + sidx) * 2 + 0) * 256 + ch);
        }
        if (PASS == 2) {
            LAS float* HS = XB;
            if (dir == 0) {
#pragma unroll
                for (int jb = 0; jb < 2; ++jb)
#pragma unroll
                    for (int r = 0; r < 16; ++r) HS[crow(r, hi) * 256 + hh * 64 + jb * 32 + r32] = hout[jb][r];
            }
            __syncthreads();
            if (dir == 1) {
#pragma unroll
                for (int jb = 0; jb < 2; ++jb)
#pragma unroll
                    for (int r = 0; r < 16; ++r) HS[crow(r, hi) * 256 + hh * 64 + jb * 32 + r32] += hout[jb][r];
            }
            __syncthreads();
            {
                const int t = tid >> 4, c0 = (tid & 15) * 16; const size_t row = (size_t)(r0 + t);
#pragma unroll
                for (int q = 0; q < 2; ++q) {
                    const int c = c0 + 8 * q;
                    const u32x4 raw = *(const u32x4*)(F.ZIN() + row * ZP + ZG + c);
                    const f32x4 h0 = *(const LAS f32x4*)(HS + t * 256 + c), h1 = *(const LAS f32x4*)(HS + t * 256 + c + 4);
                    f32x4 y0, y1;
                    y0[0] = __uint_as_float(raw.x << 16) * h0[0]; y0[1] = __uint_as_float(raw.x & 0xffff0000u) * h0[1]; y0[2] = __uint_as_float(raw.y << 16) * h0[2]; y0[3] = __uint_as_float(raw.y & 0xffff0000u) * h0[3];
                    y1[0] = __uint_as_float(raw.z << 16) * h1[0]; y1[1] = __uint_as_float(raw.z & 0xffff0000u) * h1[1]; y1[2] = __uint_as_float(raw.w << 16) * h1[2]; y1[3] = __uint_as_float(raw.w & 0xffff0000u) * h1[3];
                    *(u32x4*)(F.MIX() + row * DM + 256 + c) = pack8(y0, y1);
                }
            }
        }
        __syncthreads();
    }
}
__device__ __forceinline__ void phase_lru_carry(const Ctx& F, int b) {
    const int dir = F.tid >> 8, ch = F.tid & 255;
    float h = 0.f;
    for (int step = 0; step < NSEG; ++step) {
        const int sidx = dir ? (step < 8 ? 7 - step : NSEG - 1 - (step - 8)) : step;
        const size_t idx = (((size_t)b * NSEG + sidx) * 2 + dir) * 256 + ch;
        ((float*)(F.ws + WS_CARRY))[idx] = h;
        const f32x2 ab = *(const f32x2*)(F.ws + WS_AGG + idx * 8);
        h = ab[0] * h + ab[1];
    }
}

template <int PASS>
__device__ __forceinline__ void phase_lru_w(const Ctx& F, int l, int nseg_total) {
    constexpr int RP = 72, XP = 68, WBYTES = 35 * RP * 2 + 32 * XP * 4;
    static_assert(WBYTES % 16 == 0, "wave LDS region 16-B aligned");
    LAS float* CWL = (LAS float*)F.lds;
    LAS float* GPL = (LAS float*)(F.lds + 5120);
    LAS unsigned char* wl = F.lds + 5120 + 6144 + F.wave * WBYTES;
    LAS bf16_t* RAW = (LAS bf16_t*)wl; LAS float* XCV = (LAS float*)(wl + 35 * RP * 2);
    const int lane = F.lane, r32 = lane & 31, hi = lane >> 5;
    for (int i = F.tid; i < 5 * 256; i += NTHR) CWL[i] = (i < 1024) ? F.in[I_CONVW][l * 1024 + i] : F.in[I_CONVB][l * 256 + i - 1024];
    for (int i = F.tid; i < 2 * 3 * 256; i += NTHR) { const int dir = i / 768, w = (i / 256) % 3, ch = i & 255; const int gi = (l * 2 + dir) * 256 + ch;
        GPL[i] = (w == 0) ? -1.4426950408889634f * F.in[I_LBA][gi] : (w == 1) ? -1.4426950408889634f * F.in[I_LBX][gi] : 1.4426950408889634f * ((const float*)(F.ws + WS_C8))[gi]; }
    __syncthreads();
    const bf16_t* GW = F.wsm(l, SM_GW);
    const int rbid = (PASS == 2 && F.G % 8 == 0) ? ((F.bid & 7) ^ 4) * (F.G >> 3) + (F.bid >> 3) : (F.bid + F.G / 4) % F.G;
    const int gw = rbid * NWAVES + F.wave, NGW = F.G * NWAVES;
    for (int u = gw; u < nseg_total * 4; u += NGW) {
        const int sg = u >> 2, hh = u & 3, r0 = sg * 32;
        int seq0, slen, b, sidx;
        if (r0 < NLAT) { b = r0 >> 12; seq0 = b << 12; slen = SEQ; sidx = 8 + ((r0 - seq0) >> 5); }
        else { b = (r0 - NLAT) >> 8; seq0 = NLAT + (b << 8); slen = LC; sidx = (r0 - seq0) >> 5; }
#pragma unroll
        for (int i = 0; i < 5; ++i) {
            const int rr = (lane >> 3) + 8 * i, row = r0 - 2 + rr; u32x4 raw = {0u, 0u, 0u, 0u};
            if (rr < 35 && row >= seq0 && row < seq0 + slen) raw = *(const u32x4*)(F.ZIN() + (size_t)row * ZP + ZX + hh * 64 + (lane & 7) * 8);
            if (rr < 35) *(LAS u32x4*)(RAW + rr * RP + (lane & 7) * 8) = raw;
        }
        asm volatile("s_waitcnt lgkmcnt(0)" ::: "memory");
        bf16x8 afr[4];
#pragma unroll
        for (int ks = 0; ks < 4; ++ks) {
            const int c = ks * 16 + hi * 8, cg = hh * 64 + c;
            f32x4 a0 = *(const LAS f32x4*)(CWL + 1024 + cg), a1 = *(const LAS f32x4*)(CWL + 1024 + cg + 4);
#pragma unroll
            for (int j = 0; j < 4; ++j) {
                const u32x4 raw = *(const LAS u32x4*)(RAW + (r32 + j) * RP + c);
                const f32x4 w0 = *(const LAS f32x4*)(CWL + j * 256 + cg), w1 = *(const LAS f32x4*)(CWL + j * 256 + cg + 4);
                a0[0] += w0[0] * __uint_as_float(raw.x << 16); a0[1] += w0[1] * __uint_as_float(raw.x & 0xffff0000u); a0[2] += w0[2] * __uint_as_float(raw.y << 16); a0[3] += w0[3] * __uint_as_float(raw.y & 0xffff0000u);
                a1[0] += w1[0] * __uint_as_float(raw.z << 16); a1[1] += w1[1] * __uint_as_float(raw.z & 0xffff0000u); a1[2] += w1[2] * __uint_as_float(raw.w << 16); a1[3] += w1[3] * __uint_as_float(raw.w & 0xffff0000u);
            }
            const u32x4 pk = pack8(a0, a1); afr[ks] = __builtin_bit_cast(bf16x8, pk);
            *(LAS f32x4*)(XCV + r32 * XP + c) = a0; *(LAS f32x4*)(XCV + r32 * XP + c + 4) = a1;
        }
        asm volatile("s_waitcnt lgkmcnt(0)" ::: "memory");
        float xd[2][16];
#pragma unroll
        for (int jb = 0; jb < 2; ++jb)
#pragma unroll
            for (int r = 0; r < 16; ++r) xd[jb][r] = XCV[crow(r, hi) * XP + jb * 32 + r32];
        float hsum[2][16];
#pragma unroll
        for (int dir = 0; dir < 2; ++dir) {
            f32x16 acc[2][2];
#pragma unroll
            for (int a = 0; a < 2; ++a)
#pragma unroll
                for (int jb = 0; jb < 2; ++jb) acc[a][jb] = f32x16{};
#pragma unroll
            for (int ks = 0; ks < 4; ++ks)
#pragma unroll
                for (int gt = 0; gt < 2; ++gt)
#pragma unroll
                    for (int jb = 0; jb < 2; ++jb) {
                        const bf16x8 bfr = *(const bf16x8*)(GW + (size_t)((dir * 2 + gt) * 4 + hh) * 4096 + (size_t)(jb * 32 + r32) * 64 + ks * 16 + hi * 8);
                        acc[gt][jb] = __builtin_amdgcn_mfma_f32_32x32x16_bf16(afr[ks], bfr, acc[gt][jb], 0, 0, 0);
                    }
#pragma unroll
            for (int jb = 0; jb < 2; ++jb) {
                const int ch = hh * 64 + jb * 32 + r32;
                const float nba = GPL[dir * 768 + ch], nbx = GPL[dir * 768 + 256 + ch], k8 = GPL[dir * 768 + 512 + ch];
                float av[16], bv[16], ho[16];
#pragma unroll
                for (int r = 0; r < 16; ++r) {
                    const float ra = fast_rcp(1.0f + fast_exp2(__builtin_fmaf(acc[0][jb][r], -1.4426950408889634f, nba)));
                    const float ix = fast_rcp(1.0f + fast_exp2(__builtin_fmaf(acc[1][jb][r], -1.4426950408889634f, nbx)));
                    const float a = fast_exp2(k8 * ra);
                    av[r] = a; bv[r] = __builtin_amdgcn_sqrtf((1.0f - a) * (1.0f + a)) * (ix * xd[jb][r]);
                }
                const size_t idx = (((size_t)b * NSEG + sidx) * 2 + dir) * 256 + ch;
                if (dir) lru_scan<PASS, 1>(av, bv, hi, ho, F.ws, idx); else lru_scan<PASS, 0>(av, bv, hi, ho, F.ws, idx);
                if (PASS == 2) {
#pragma unroll
                    for (int r = 0; r < 16; ++r) hsum[jb][r] = dir ? hsum[jb][r] + ho[r] : ho[r];
                }
            }
        }
        if (PASS == 2) {
#pragma unroll
            for (int jb = 0; jb < 2; ++jb)
#pragma unroll
                for (int r = 0; r < 16; ++r) XCV[crow(r, hi) * XP + jb * 32 + r32] = hsum[jb][r];
            asm volatile("s_waitcnt lgkmcnt(0)" ::: "memory");
            const int t = lane >> 1, c0 = (lane & 1) * 32; const size_t row = (size_t)(r0 + t);
#pragma unroll
            for (int q = 0; q < 4; ++q) {
                const int c = c0 + 8 * q;
                const u32x4 raw = *(const u32x4*)(F.ZIN() + row * ZP + ZG + hh * 64 + c);
                const f32x4 h0 = *(const LAS f32x4*)(XCV + t * XP + c), h1 = *(const LAS f32x4*)(XCV + t * XP + c + 4);
                f32x4 y0, y1;
                y0[0] = __uint_as_float(raw.x << 16) * h0[0]; y0[1] = __uint_as_float(raw.x & 0xffff0000u) * h0[1]; y0[2] = __uint_as_float(raw.y << 16) * h0[2]; y0[3] = __uint_as_float(raw.y & 0xffff0000u) * h0[3];
                y1[0] = __uint_as_float(raw.z << 16) * h1[0]; y1[1] = __uint_as_float(raw.z & 0xffff0000u) * h1[1]; y1[2] = __uint_as_float(raw.w << 16) * h1[2]; y1[3] = __uint_as_float(raw.w & 0xffff0000u) * h1[3];
                *(u32x4*)(F.MIX() + row * DM + 256 + hh * 64 + c) = pack8(y0, y1);
            }
            asm volatile("s_waitcnt lgkmcnt(0)" ::: "memory");
        }
    }
    __syncthreads();
}

namespace att {
constexpr int QBLK = 32, KVBLK = 64;
constexpr float SCALE = 0.10206207261596577f;
constexpr float THR = 8.f;
constexpr int SHM_K = KVBLK * 256, SHM_V = KVBLK * 64 * 2;
constexpr int LDS_BYTES = 4 * SHM_V + 4 * SHM_K + NWAVES * 64 * 4;
#define KSWZ(row, colB) ((row) * 256 + ((colB) ^ (((row) & 7) << 4)))
#define SBAR() __builtin_amdgcn_sched_barrier(0)
constexpr float PSH = 5.f;
constexpr float THR2 = PSH + 3.5f;
template <bool FIRST>
__device__ __forceinline__ void partialSM(f32x16& p0, f32x16& p1, float& m_reg, f32x16& negm, float& alpha) {
    float pmax = fmaxf(p0[0], p1[0]);
#pragma unroll
    for (int r = 1; r < 16; ++r) pmax = fmaxf(fmaxf(pmax, p0[r]), p1[r]);
    pmax = max32_f(pmax);
    alpha = 1.f;
    if (FIRST || !__all(pmax <= THR2)) {
        const float dl = FIRST ? pmax - PSH : fmaxf(pmax - PSH, 0.f);
        m_reg += dl; alpha = FIRST ? 1.f : __builtin_amdgcn_exp2f(-dl);
#pragma unroll
        for (int r = 0; r < 16; ++r) { p0[r] -= dl; p1[r] -= dl; negm[r] = -m_reg; }
    }
#pragma unroll
    for (int r = 0; r < 16; ++r) p0[r] = __builtin_amdgcn_exp2f(p0[r]);
}
__device__ __forceinline__ void finishSM(f32x16& p0, f32x16& p1, long& pa0, long& pa1, long& pa2, long& pa3) {
#pragma unroll
    for (int r = 0; r < 16; ++r) p1[r] = __builtin_amdgcn_exp2f(p1[r]);
#define PK4(P, BASE, OUT) do { int x, y; asm volatile("" : "=v"(x), "=v"(y));              \
    x = __builtin_amdgcn_cvt_pk_fp8_f32(P[BASE + 0], P[BASE + 1], x, false); x = __builtin_amdgcn_cvt_pk_fp8_f32(P[BASE + 2], P[BASE + 3], x, true); \
    y = __builtin_amdgcn_cvt_pk_fp8_f32(P[BASE + 4], P[BASE + 5], y, false); y = __builtin_amdgcn_cvt_pk_fp8_f32(P[BASE + 6], P[BASE + 7], y, true); \
    unsigned ux = (unsigned)x, uy = (unsigned)y; pl32swap(ux, uy); OUT = (long)(((unsigned long long)uy << 32) | (unsigned long long)ux); } while (0)
    PK4(p0, 0, pa0); PK4(p0, 8, pa1); PK4(p1, 0, pa2); PK4(p1, 8, pa3);
#undef PK4
}
#define KSWZ16(row, colB) ((row) * 128 + (((((colB) >> 4) ^ ((row) & 7))) << 4) + ((colB) & 15))
typedef long l64x4 __attribute__((ext_vector_type(4)));
#define MFMA64(A8, B8, C) __builtin_amdgcn_mfma_scale_f32_32x32x64_f8f6f4(__builtin_bit_cast(i32x8, A8), __builtin_bit_cast(i32x8, B8), C, 0, 0, 0, 0x7f7f7f7f, 0, 0x7f7f7f7f)
typedef unsigned u32x8 __attribute__((ext_vector_type(8)));
__device__ __forceinline__ void qkt(f32x16& p0, f32x16& p1, const LAS char* Ks, const u32x8& q8, const long* qr, const f32x16& negm, int r32, int hi) {
    const u32x4 a0l = *(const LAS u32x4*)(Ks + KSWZ16(r32, hi * 32)), a0h = *(const LAS u32x4*)(Ks + KSWZ16(r32, hi * 32 + 16));
    const u32x4 a1l = *(const LAS u32x4*)(Ks + KSWZ16(32 + r32, hi * 32)), a1h = *(const LAS u32x4*)(Ks + KSWZ16(32 + r32, hi * 32 + 16));
    const u32x4 r0 = *(const LAS u32x4*)(Ks + KSWZ16(r32, 64 + hi * 16)), r1 = *(const LAS u32x4*)(Ks + KSWZ16(32 + r32, 64 + hi * 16));
    const u32x8 a0 = __builtin_shufflevector(a0l, a0h, 0, 1, 2, 3, 4, 5, 6, 7), a1 = __builtin_shufflevector(a1l, a1h, 0, 1, 2, 3, 4, 5, 6, 7);
    p0 = MFMA64(a0, q8, negm); p1 = MFMA64(a1, q8, negm);
    p0 = __builtin_amdgcn_mfma_f32_32x32x16_fp8_fp8((long)(((unsigned long long)r0[1] << 32) | r0[0]), qr[0], p0, 0, 0, 0);
    p1 = __builtin_amdgcn_mfma_f32_32x32x16_fp8_fp8((long)(((unsigned long long)r1[1] << 32) | r1[0]), qr[0], p1, 0, 0, 0);
    p0 = __builtin_amdgcn_mfma_f32_32x32x16_fp8_fp8((long)(((unsigned long long)r0[3] << 32) | r0[2]), qr[1], p0, 0, 0, 0);
    p1 = __builtin_amdgcn_mfma_f32_32x32x16_fp8_fp8((long)(((unsigned long long)r1[3] << 32) | r1[2]), qr[1], p1, 0, 0, 0);
}
constexpr int SHM_V8 = 8 * 512, VB8 = 2 * SHM_V8;
template <int D0> __device__ __forceinline__ void pv_one(f32x16& od, int vb, long pa0, long pa1, long pa2, long pa3) {
    const long v0 = *(const LAS long*)(size_t)(unsigned)(vb + D0 * 256), v1 = *(const LAS long*)(size_t)(unsigned)(vb + D0 * 256 + 1024);
    const long v2 = *(const LAS long*)(size_t)(unsigned)(vb + D0 * 256 + 2048), v3 = *(const LAS long*)(size_t)(unsigned)(vb + D0 * 256 + 3072);
    const l64x4 p4 = {pa0, pa1, pa2, pa3}, v4 = {v0, v1, v2, v3};
    od = MFMA64(v4, p4, od);
}
__device__ __forceinline__ void pv_d0(f32x16* o, int vb, long pa0, long pa1, long pa2, long pa3, const l64x4& ones4) {
    pv_one<0>(o[0], vb, pa0, pa1, pa2, pa3); pv_one<1>(o[1], vb, pa0, pa1, pa2, pa3);
    const l64x4 p4 = {pa0, pa1, pa2, pa3}; o[2] = MFMA64(ones4, p4, o[2]);
}

__device__ __forceinline__ void attn_unit(const bf16_t* Qg, const unsigned char* VT8g, const unsigned char* K8g, const unsigned char* R8g, bf16_t* MIXg,
                                          int qrow0, int b, int h, int NT2, bool ctxq, LAS char* lds, int tid) {
    const int wid = tid >> 6, lane = tid & 63, r32 = lane & 31, hi = lane >> 5;
    constexpr int VB = VB8, KB = 2 * SHM_K;
    LAS char* V_lds = lds; LAS char* K_lds = lds + 4 * SHM_V;
    float m_reg = 0.f; f32x16 o[3] = {}; f32x16 negm = f32x16{};
    l64x4 ones4 = {0x3838383838383838L, 0x3838383838383838L, 0x3838383838383838L, 0x3838383838383838L}; asm volatile("" : "+v"(ones4));
    const unsigned char* Qw = (const unsigned char*)Qg + (size_t)(qrow0 + wid * QBLK + r32) * QP + h * DQK;
    const u32x4 q8l = *reinterpret_cast<const u32x4*>(Qw + hi * 32), q8h = *reinterpret_cast<const u32x4*>(Qw + hi * 32 + 16);
    const u32x8 q8 = __builtin_shufflevector(q8l, q8h, 0, 1, 2, 3, 4, 5, 6, 7);
    long qr[2]; { const u32x4 t = *reinterpret_cast<const u32x4*>(Qw + 64 + hi * 16); qr[0] = (long)(((unsigned long long)t[1] << 32) | t[0]); qr[1] = (long)(((unsigned long long)t[3] << 32) | t[2]); }
    const int srow = tid >> 3, sc8 = (tid & 7) * 8, rrow = tid >> 2, rc8 = (tid & 3) * 8;
    const int vkg = tid >> 5, vdp = tid & 31, vst = vkg * 512 + vdp * 16, kst = KSWZ16(srow, sc8), rst = (rrow >> 6) * SHM_K + KSWZ16(rrow & 63, 64 + rc8);
    const int vb0 = (int)(unsigned)(size_t)V_lds + r32 * 8 + hi * 512;
    const int kbase_lat = b * SEQ, kbase_ctx = NLAT + b * LC;
#define KROW(T) (ctxq ? kbase_ctx + (T) * 128 : ((T) < 32 ? kbase_lat + (T) * 128 : kbase_ctx + ((T) - 32) * 128))
    u32x4 sv; u32x2 sk0, sk1, sr;
#define SLOAD(T) do { const size_t _r = (size_t)KROW(T); \
    sk0 = *reinterpret_cast<const u32x2*>(K8g + (_r + srow) * 512 + h * 64 + sc8); sk1 = *reinterpret_cast<const u32x2*>(K8g + (_r + 64 + srow) * 512 + h * 64 + sc8); \
    sv = *reinterpret_cast<const u32x4*>(VT8g + ((_r >> 3) + vkg) * 4096 + (size_t)(h * 64 + 2 * vdp) * 8); \
    sr = *reinterpret_cast<const u32x2*>(R8g + (_r + rrow) * 32 + rc8); } while (0)
#define SWRITE(bf) do { *(LAS u32x4*)(V_lds + (bf) * VB + vst) = sv; \
    *(LAS u32x2*)(K_lds + (bf) * KB + kst) = sk0; *(LAS u32x2*)(K_lds + (bf) * KB + SHM_K + kst) = sk1; *(LAS u32x2*)(K_lds + (bf) * KB + rst) = sr; } while (0)
#define RESC(a) do { if (__any((a) < 1.f)) { _Pragma("unroll") for (int d = 0; d < 3; ++d) _Pragma("unroll") for (int r = 0; r < 16; ++r) o[d][r] *= (a); } } while (0)
    f32x16 pA0, pA1, pB0, pB1; float alA, alB; long pa0, pa1, pa2, pa3;
    SLOAD(0); SWRITE(0); if (1 < NT2) SLOAD(1);
    __syncthreads();
    qkt(pA0, pA1, K_lds, q8, qr, negm, r32, hi); partialSM<true>(pA0, pA1, m_reg, negm, alA);
    if (1 < NT2) { SWRITE(1); if (2 < NT2) SLOAD(2); }
    SBAR(); qkt(pB0, pB1, K_lds + SHM_K, q8, qr, negm, r32, hi);
    finishSM(pA0, pA1, pa0, pa1, pa2, pa3); SBAR();
    pv_d0(o, vb0, pa0, pa1, pa2, pa3, ones4); partialSM<false>(pB0, pB1, m_reg, negm, alB); RESC(alB);
    int pb = 0, cb = 1, nb = 2;
    for (int T = 1; T < NT2; ++T) {
        __syncthreads();
        SBAR(); qkt(pA0, pA1, K_lds + cb * KB, q8, qr, negm, r32, hi);
        finishSM(pB0, pB1, pa0, pa1, pa2, pa3); SBAR();
        pv_d0(o, vb0 + pb * VB + SHM_V8, pa0, pa1, pa2, pa3, ones4); partialSM<false>(pA0, pA1, m_reg, negm, alA); RESC(alA);
        if (T + 1 < NT2) { SWRITE(nb); if (T + 2 < NT2) SLOAD(T + 2); }
        SBAR(); qkt(pB0, pB1, K_lds + cb * KB + SHM_K, q8, qr, negm, r32, hi);
        finishSM(pA0, pA1, pa0, pa1, pa2, pa3); SBAR();
        pv_d0(o, vb0 + cb * VB, pa0, pa1, pa2, pa3, ones4); partialSM<false>(pB0, pB1, m_reg, negm, alB); RESC(alB);
        const int t_ = pb; pb = cb; cb = nb; nb = t_;
    }
    finishSM(pB0, pB1, pa0, pa1, pa2, pa3); SBAR();
    pv_d0(o, vb0 + pb * VB + SHM_V8, pa0, pa1, pa2, pa3, ones4);
    const float rl = __builtin_amdgcn_rcpf(o[2][0]);
    bf16_t* Ow = MIXg + (size_t)(qrow0 + wid * QBLK + r32) * DM + 512 + h * 64 + hi * 8;
#pragma unroll
    for (int d0 = 0; d0 < 2; ++d0)
#pragma unroll
        for (int g = 0; g < 4; g += 2) {
            unsigned a0 = cvt_pk_bf16(o[d0][4 * g] * rl, o[d0][4 * g + 1] * rl), a1 = cvt_pk_bf16(o[d0][4 * g + 2] * rl, o[d0][4 * g + 3] * rl);
            unsigned b0 = cvt_pk_bf16(o[d0][4 * g + 4] * rl, o[d0][4 * g + 5] * rl), b1 = cvt_pk_bf16(o[d0][4 * g + 6] * rl, o[d0][4 * g + 7] * rl);
            pl32swap(a0, b0); pl32swap(a1, b1);
            *(u32x4*)(Ow + d0 * 32 + g * 8) = (u32x4){a0, a1, b0, b1};
        }
    __syncthreads();
#undef KROW
#undef SLOAD
#undef SWRITE
#undef RESC
}
#undef KSWZ
#undef SBAR
}

__device__ __forceinline__ void phase_attn(const Ctx& F, bool last) {
    LAS char* lds = (LAS char*)F.lds;
    const int v = (F.G % 8 == 0) ? (F.bid & 7) * (F.G >> 3) + (F.bid >> 3) : F.bid;
    const int nun = 2048 + (last ? 0 : 128);
#pragma nounroll
    for (int u = v; u < nun; u += F.G) {
        const bool ctxq = u >= 2048;
        const int uu = ctxq ? u - 2048 : u;
        const int b = ctxq ? (uu >> 3) : (uu >> 7), h = ctxq ? (uu & 7) : ((uu >> 4) & 7), qb = uu & 15;
        att::attn_unit(F.Q(), F.VT8(), F.K8(), F.R8(), F.MIX(), ctxq ? NLAT + b * LC : b * SEQ + qb * 256, b, h, ctxq ? 2 : 34, ctxq, lds, F.tid);
    }
}


constexpr int LDS_BYTES = 147456;
constexpr int XB_ST_OFF = LDS_BYTES - 64;
constexpr int NPH = 7 + 2 * MOE_NR;
constexpr int NSTEPS = 2 + DEPTH * NPH;

__device__ __forceinline__ void lru_carry_all(const Ctx& F) {
    LAS f32x2* cmp = (LAS f32x2*)F.lds;
    for (int c0 = F.bid * 32; c0 < NB * 2 * 256; c0 += F.G * 32) {
        const int j = F.tid & 31, pt = F.tid >> 5, c = c0 + j, b = c >> 9, dir = (c >> 8) & 1, ch = c & 255;
        f32x2 ab[17]; unsigned idx[17];
        if (F.tid < 256) {
#pragma unroll
            for (int k = 0; k < 17; ++k) { const int step = 17 * pt + k; const int sidx = dir ? (step < 8 ? 7 - step : NSEG - 1 - (step - 8)) : step;
                idx[k] = (unsigned)(((b * NSEG + sidx) * 2 + dir) * 256 + ch); ab[k] = *(const f32x2*)(F.ws + WS_AGG + (size_t)idx[k] * 8); }
            float A = 1.f, B = 0.f;
#pragma unroll
            for (int k = 0; k < 17; ++k) { B = ab[k][0] * B + ab[k][1]; A = A * ab[k][0]; }
            cmp[pt * 32 + j] = (f32x2){A, B};
        }
        __syncthreads();
        if (F.tid < 256) {
            float h = 0.f;
#pragma unroll
            for (int q = 0; q < 7; ++q) { const f32x2 m = cmp[q * 32 + j]; h = (q < pt) ? m[0] * h + m[1] : h; }
#pragma unroll
            for (int k = 0; k < 17; ++k) { ((float*)(F.ws + WS_CARRY))[idx[k]] = h; h = ab[k][0] * h + ab[k][1]; }
        }
        __syncthreads();
    }
}

__global__ void __launch_bounds__(NTHR, 2) mega_fwd(Params P) {
    extern __shared__ __attribute__((aligned(16))) unsigned char lds_raw[];
    Ctx F; F.in = P.in; F.out = P.out; F.ws = P.ws;
    F.tid = threadIdx.x; F.lane = F.tid & 63; F.wave = __builtin_amdgcn_readfirstlane(F.tid >> 6); F.G = gridDim.x; F.bid = blockIdx.x;
    F.lds = (LAS unsigned char*)lds_raw;
    volatile LAS unsigned* st = (volatile LAS unsigned*)(F.lds + XB_ST_OFF);
    if (F.tid < 4) st[F.tid] = 0u;
    __syncthreads();
    const int lo = P.ph_lo, hi = P.ph_hi;
    const int wave0 = __builtin_amdgcn_readfirstlane(threadIdx.x >> 6);
    XcdBarrier bar; bar.bar = F.ctl() + CW_BAR; bar.x = 0; bar.st = st;
    if (hi - lo > 1) bar = xcd_barrier_post(F.ctl() + CW_BAR, st);
#ifndef PH_MASK
#define PH_MASK 0xffffffffu
#endif
#define PHM(k) ((PH_MASK >> (k)) & 1u)
#ifndef REP_MASK
#define REP_MASK 0u
#endif
#define REPQ(k) ((REP_MASK >> (k)) & 1u)
#define IN(s) (lo <= (s) && (s) < hi)
#define SEAM(s) do { if ((s) + 1 < hi) { xcd_barrier(bar); if (REPQ(20)) xcd_barrier(bar); } } while (0)
#define OPQ() do { int _t = wave0 * 64 + (int)__builtin_amdgcn_mbcnt_hi(~0u, __builtin_amdgcn_mbcnt_lo(~0u, 0u)); asm volatile("" : "+v"(_t)); F.tid = _t; F.lane = _t & 63; \
    unsigned long long _z = 0; int _w = wave0, _b = blockIdx.x, _g = gridDim.x; asm volatile("" : "+s"(_z), "+s"(_w), "+s"(_b), "+s"(_g)); F.ws = P.ws + _z; F.out = P.out + _z; F.wave = _w; F.bid = _b; F.G = _g; F.in = P.in + _z; F.lds = (LAS unsigned char*)lds_raw + (unsigned)_z; } while (0)

#define ARRIVE(w) do { asm volatile("s_waitcnt vmcnt(0)" ::: "memory"); __syncthreads(); \
        if (threadIdx.x == 0) { __builtin_amdgcn_fence(__ATOMIC_RELEASE, "agent"); asm volatile("s_waitcnt vmcnt(0)" ::: "memory"); (void)xb_add(F.ctl() + (w), 1u); } } while (0)
#define AWAIT(w) do { if (threadIdx.x == 0) { unsigned* cw = F.ctl() + (w); unsigned* bw = F.ctl() + CW_BAR; asm volatile("" : "+s"(cw), "+s"(bw)); \
        XB_SPIN(xb_ld(cw) != (unsigned)F.G, bw); __builtin_amdgcn_fence(__ATOMIC_ACQUIRE, "agent"); asm volatile("s_waitcnt vmcnt(0)" ::: "memory"); } __syncthreads(); } while (0)

    if (PHM(0) && IN(0)) { OPQ(); phase_prologue(F); if (REPQ(0)) { __syncthreads(); OPQ(); phase_prologue(F); } SEAM(0); }

    for (int l = 0; l < DEPTH; ++l) {
        const int s0 = 1 + l * NPH;
        if (hi <= s0 || lo >= s0 + NPH) continue;
        const bool last = (l == DEPTH - 1), moe = (l & 1);
        const int nrows = last ? NLAT : NTOK, nMr = nrows / 256;
        if (PHM(1) && IN(s0 + 0)) { OPQ();
            if (l == 0) phase_norm<0, true>(F, l, NTOK, false, 0); else phase_norm<0>(F, l, NTOK, (l == 2), 0);
            if (REPQ(1) && l != 2) { OPQ(); phase_norm<0>(F, l, NTOK, false, 0); }
            OPQ();
            if (l == 2) { __syncthreads(); cvt_moe_weights(F, 1, (LAS float*)(F.lds + F.wave * 16384)); OPQ(); cvt8_run(F, 1, (LAS float*)(F.lds + 135168)); }
            SEAM(s0 + 0);
        }
        if (PHM(2) && IN(s0 + 1)) { _Pragma("unroll") for (int _rp = 0; _rp < 1 + (int)REPQ(2); ++_rp) { OPQ();
            pg8::StaticOrder S; S.init(NTOK / 256, ZP / 256, F.G, F.bid);
            if constexpr (W_IN_I8) { pg8::Gemm g{(const bf16_t*)F.H8(), F.wsm(l, SM_IN), DM / 2, DM / 2};
                EpiIn E{F.ZIN(), F.SSP(), F.ROPE(), F.HS(), F.wsc(WSC_IN) + (size_t)l * ZP, F.R8()};
                pg8::gemm_phase<EpiIn, pg8::StaticOrder, false, 1>(F.lds, g, S, E, F.tid); }
            else { pg8::Gemm g{F.H(), F.wsm(l, SM_IN), DM, DM}; EpiInB E{F.ZIN(), F.SSP(), F.ROPE()};
                pg8::gemm_phase<EpiInB, pg8::StaticOrder, false, 0>(F.lds, g, S, E, F.tid); }
            } SEAM(s0 + 1);
        }
        if (PHM(3) && IN(s0 + 2)) { _Pragma("unroll") for (int _rp = 0; _rp < 1 + (int)REPQ(3); ++_rp) { OPQ();
            if (PHM(13)) { pg8::Gemm g{F.ZIN() + ZQ, F.wsm(l, SM_Q), QLORA, ZP}; pg8::StaticOrder S; S.init(NTOK / 256, QP / 256, F.G, F.bid);
              EpiQ E{F.Q(), F.SSP(), F.ROPE()}; pg8::gemm_phase<EpiQ, pg8::StaticOrder>(F.lds, g, S, E, F.tid);
              if (REPQ(13)) { OPQ(); pg8::gemm_phase<EpiQ, pg8::StaticOrder>(F.lds, g, S, E, F.tid); } }
            OPQ();
            if (PHM(14)) { pg8::Gemm g{F.ZIN() + ZKV, F.wsm(l, SM_KV), KVLORA, ZP}; pg8::StaticOrder S; S.init(NTOK / 256, 512 / 256, F.G, (F.bid + F.G - 48) % F.G);
              EpiKV E{F.KV(), F.SSP(), F.K8()}; pg8::gemm_phase<EpiKV, pg8::StaticOrder>(F.lds, g, S, E, F.tid);
              if (REPQ(14)) { OPQ(); pg8::gemm_phase<EpiKV, pg8::StaticOrder>(F.lds, g, S, E, F.tid); } }
            OPQ();
            if (PHM(14)) { pg8::Gemm g{F.wsm(l, SM_KV) + (size_t)512 * KVLORA, F.ZIN() + ZKV, KVLORA, KVLORA, ZP}; pg8::StaticOrder S; S.init(512 / 256, NTOK / 256, F.G, (F.bid + F.G - 80) % F.G);
              EpiVT E{F.VT8(), F.SSP()}; pg8::gemm_phase<EpiVT, pg8::StaticOrder>(F.lds, g, S, E, F.tid); }
            OPQ();
            if (PHM(16)) phase_lru_w<1>(F, l, NTOK / 32);
            if (REPQ(16)) { OPQ(); phase_lru_w<1>(F, l, NTOK / 32); }
            OPQ();
            if (PHM(15)) phase_sgu(F, l, last ? NLAT / 128 : NTOK / 128, (F.bid + F.G / 2) % F.G, F.G);
            if (REPQ(15)) { OPQ(); phase_sgu(F, l, last ? NLAT / 128 : NTOK / 128, F.bid, F.G); }
            xcd_barrier(bar);
            }
        }
        if (PHM(4) && IN(s0 + 3)) { _Pragma("unroll") for (int _rp = 0; _rp < 1 + (int)REPQ(4); ++_rp) { OPQ();
            if (PHM(17)) lru_carry_all(F);
            ARRIVE(CW_CARRY + l * 64);
            OPQ();
            if (PHM(18)) phase_attn(F, last);
            OPQ();
            AWAIT(CW_CARRY + l * 64);
            OPQ();
            if (PHM(5)) phase_lru_w<2>(F, l, last ? NLAT / 32 : NTOK / 32);
            } SEAM(s0 + 3);
        }
        if (PHM(6) && IN(s0 + 5)) { OPQ();
            pg8::Gemm g{F.MIX(), F.wsm(l, SM_OUT), DM, DM}; pg8::StaticOrder S; S.init(nMr, DM / 256, F.G, F.bid);
            EpiRes E{l == 0 ? F.in[I_X] : nullptr, l == 0 ? F.in[I_CTX] : nullptr, F.XB(), F.mod(l) + 2048, nullptr};
            pg8::gemm_phase<EpiRes, pg8::StaticOrder>(F.lds, g, S, E, F.tid);
            SEAM(s0 + 5);
        }
        if (PHM(7) && IN(s0 + 6)) { OPQ(); if (moe) phase_norm<2>(F, l, nrows, false, 0); else phase_norm<1>(F, l, nrows, false, 0); SEAM(s0 + 6); }
        if (!moe) {
            if (PHM(8) && IN(s0 + 7)) { _Pragma("unroll") for (int _rp = 0; _rp < 1 + (int)REPQ(8); ++_rp) { OPQ();
                pg8::Gemm g{(const bf16_t*)F.H8(), F.wffn(l >> 1, FF_13), DM / 2, DM / 2}; pg8::StaticOrder S; S.init(nMr, 2 * DFF / 256, F.G, F.bid);
                EpiGlu E{F.HMID(), DFF, F.HS(), F.wsc(WSC_FF) + (size_t)(l >> 1) * 2 * DFF, nullptr, nullptr, nullptr, 0, 1};
                pg8::gemm_phase<EpiGlu, pg8::StaticOrder, false, 1>(F.lds, g, S, E, F.tid);
                } SEAM(s0 + 7);
            }
            if (PHM(9) && IN(s0 + 8)) { OPQ();
                pg8::StaticOrder S; S.init(nMr, DM / 256, F.G, F.bid);
                if constexpr (DOWN_FP8) { pg8::Gemm g{F.HMID(), F.wffn(l >> 1, FF_2), DFF / 2, DFF / 2};
                    EpiRes E{nullptr, nullptr, F.XB(), F.mod(l) + 5120, F.wsc(WSC_F2) + (size_t)(l >> 1) * DM}; pg8::gemm_phase<EpiRes, pg8::StaticOrder, false, 2>(F.lds, g, S, E, F.tid); }
                else { pg8::Gemm g{F.HMID(), F.wffn(l >> 1, FF_2), DFF, DFF};
                    EpiRes E{nullptr, nullptr, F.XB(), F.mod(l) + 5120, nullptr}; pg8::gemm_phase<EpiRes, pg8::StaticOrder>(F.lds, g, S, E, F.tid); }
                SEAM(s0 + 8);
            }
        } else {
#pragma nounroll
            for (int r = 0; r < MOE_NR; ++r) {
                if (PHM(10) && IN(s0 + 7 + 2 * r)) { _Pragma("unroll") for (int _rp = 0; _rp < 1 + (int)REPQ(10); ++_rp) { OPQ();
                    LAS int* tab = (LAS int*)(F.lds + LDS_BYTES - 512); if (r == 0) moe_table(F, l >> 1, tab);
                    MoeOrder S; S.tab = tab; S.pm0 = r * MOE_RT; S.nN = 2 * DFE / 256; S.list = (const int*)(F.ws + WS_LIST);
                    int nM = __builtin_amdgcn_readfirstlane(tab[NE]) - S.pm0; nM = nM < 0 ? 0 : (nM > MOE_RT ? MOE_RT : nM); S.base.init(nM, S.nN, F.G, F.bid);
                    pg8::Gemm g{(const bf16_t*)F.H8(), F.wmoe(MO_13), DM / 2, DM / 2}; EpiGlu E{F.HMID(), DFE, F.HS(), F.wsc(WSC_MO), S.list, (const float*)(F.ws + WS_RSC), tab, S.pm0, S.nN};
                    pg8::gemm_phase<EpiGlu, MoeOrder, true, 1>(F.lds, g, S, E, F.tid);
                    } SEAM(s0 + 7 + 2 * r);
                }
                if (PHM(11) && IN(s0 + 8 + 2 * r)) { _Pragma("unroll") for (int _rp = 0; _rp < 1 + (int)REPQ(11); ++_rp) { OPQ();
                    LAS int* tab = (LAS int*)(F.lds + LDS_BYTES - 512);
                    MoeOrder S; S.tab = tab; S.pm0 = r * MOE_RT; S.nN = DM / 256; S.list = (const int*)(F.ws + WS_LIST);
                    int nM = __builtin_amdgcn_readfirstlane(tab[NE]) - S.pm0; nM = nM < 0 ? 0 : (nM > MOE_RT ? MOE_RT : nM); S.base.init(nM, S.nN, F.G, F.bid);
                    if constexpr (DOWN_FP8) { pg8::Gemm g{F.HMID(), F.wmoe(MO_2), DFE / 2, DFE / 2}; EpiBf E{F.YPAD(), DM, S.pm0, F.wsc(WSC_M2), S.nN};
                        pg8::gemm_phase<EpiBf, MoeOrder, false, 2>(F.lds, g, S, E, F.tid); }
                    else { pg8::Gemm g{F.HMID(), F.wmoe(MO_2), DFE, DFE}; EpiBf E{F.YPAD(), DM, S.pm0, nullptr, S.nN};
                        pg8::gemm_phase<EpiBf, MoeOrder, false, 0>(F.lds, g, S, E, F.tid); }
                    } SEAM(s0 + 8 + 2 * r);
                }
            }
        }
    }
    if (PHM(12) && IN(NSTEPS - 1)) { OPQ(); } if (PHM(12) && IN(NSTEPS - 1)) phase_norm<3>(F, DEPTH - 1, NLAT, true, 1);
#undef IN
#undef SEAM
}

#if CHECK
__device__ __forceinline__ unsigned hsh(unsigned x) { x ^= x >> 16; x *= 0x7feb352dU; x ^= x >> 15; x *= 0x846ca68bU; x ^= x >> 16; return x; }
__device__ __forceinline__ void ck_report(unsigned* slot, float got, float ref, float atol, float rtol) {
    float e = fabsf(got - ref) / (atol + rtol * fabsf(ref)); if (!(e == e)) e = 1e30f;
    atomicMax(slot, __float_as_uint(e));
}
__device__ __forceinline__ float rbf(float x) { return bf2f(f2bf(x)); }
__device__ __forceinline__ int rope_unperm(int pp) { const int half = pp >> 4, w = pp & 15, i = w >> 1, s = w & 1; return half * 16 + s * 8 + i; }
__device__ __forceinline__ float gelu_ref(float x) { return 0.5f * x * (1.0f + tanhf(0.7978845608028654f * (x + 0.044715f * x * x * x))); }
__device__ __forceinline__ float silu_ref(float x) { return x / (1.0f + expf(-x)); }
#define CKW(off) ((const bf16_t*)(P.ws + (off)))
struct CkP { const float* in[N_IN]; float* out; unsigned char* ws; };

__global__ void ck_mod(CkP P, unsigned* slot) {
    const unsigned t = blockIdx.x * blockDim.x + threadIdx.x; const unsigned r = hsh(t * 3 + 1);
    const int l = r & 3, b = (r >> 2) % 17, n = (r >> 8) % 6144;
    double a = 0; for (int k = 0; k < DM; ++k) { const float c = b < 16 ? P.in[I_C][b * DM + k] : P.in[I_CCTX][k]; a += (double)silu_ref(c) * P.in[I_WMOD][((size_t)l * DM + k) * 6144 + n]; }
    a += P.in[I_BMOD][l * 6144 + n];
    ck_report(slot, ((const float*)(P.ws + WS_MOD))[((size_t)l * 17 + b) * 6144 + n], (float)a, 2e-3f, 2e-3f);
}
__global__ void ck_wcvt(CkP P, int l, int mi, unsigned* slot) {
    const unsigned t = blockIdx.x * blockDim.x + threadIdx.x; const unsigned r = hsh(t * 7 + 5), r2 = hsh(r + 99);
    const size_t SMB = WS_WSM + (size_t)l * SM_BYTES;
    { const int n = r % ZP, k = r2 % DM; float ref = 0.f; if (n < D_IN) { const int c = n < ZR ? n : ZR + rope_unperm(n - ZR); ref = rbf(P.in[I_WIN][((size_t)l * DM + k) * D_IN + c]); }
      ck_report(slot, bf2f(CKW(SMB + SM_IN)[(size_t)n * DM + k]), ref, 1e-6f, 1e-6f); }
    { const int n = r % DM, k = r2 % DM; ck_report(slot, bf2f(CKW(SMB + SM_OUT)[(size_t)n * DM + k]), rbf(P.in[I_WOUT][((size_t)l * DM + k) * DM + n]), 1e-6f, 1e-6f); }
    { const int n = r % QP, k = r2 % QLORA; const int h = n / DQK, e = n % DQK, c = e < 64 ? n : h * DQK + 64 + rope_unperm(e - 64);
      ck_report(slot, bf2f(CKW(SMB + SM_Q)[(size_t)n * QLORA + k]), rbf(P.in[I_WUQ][((size_t)l * QLORA + k) * QP + c] * P.in[I_QN][l * QLORA + k]), 1e-6f, 1e-6f); }
    { const int n = r % KVP, k = r2 % KVLORA; const float w = n < 512 ? P.in[I_WUK][((size_t)l * KVLORA + k) * 512 + n] : P.in[I_WUV][((size_t)l * KVLORA + k) * 512 + n - 512];
      ck_report(slot, bf2f(CKW(SMB + SM_KV)[(size_t)n * KVLORA + k]), rbf(w * P.in[I_KVN][l * KVLORA + k]), 1e-6f, 1e-6f); }
    { const int idx = r % (4 * 128 * 128); ck_report(slot, bf2f(CKW(SMB + SM_SGU)[idx]), rbf(P.in[I_SGUW][(size_t)l * 4 * 128 * 128 + idx]), 1e-6f, 1e-6f); }
    { const int mat = r % 16, j = (r >> 4) % 64, i = r2 % 64, d = mat >> 3, gate = (mat >> 2) & 1, hh = mat & 3;
      const float w = (gate ? P.in[I_LWX] : P.in[I_LWA])[((((size_t)l * 2 + d) * 4 + hh) * 64 + i) * 64 + j];
      ck_report(slot, bf2f(CKW(SMB + SM_GW)[(size_t)mat * 4096 + j * 64 + i]), rbf(w), 1e-6f, 1e-6f); }
    if (!(l & 1)) { const int i = l >> 1; const size_t FB = WS_FFN + (size_t)i * FF_BYTES;
      { const int n = r % (2 * DFF), k = r2 % DM, tile = n >> 8, wi = n & 255, sec = wi >> 7, c = tile * 128 + (wi & 127);
        ck_report(slot, bf2f(CKW(FB + FF_13)[(size_t)n * DM + k]), rbf((sec ? P.in[I_F3] : P.in[I_F1])[((size_t)i * DM + k) * DFF + c]), 1e-6f, 1e-6f); }
      { const int n = r % DM, k = r2 % DFF; ck_report(slot, bf2f(CKW(FB + FF_2)[(size_t)n * DFF + k]), rbf(P.in[I_F2][((size_t)i * DFF + k) * DM + n]), 1e-6f, 1e-6f); } }
    if (mi >= 0) { const int e = (r >> 20) % NE;
      { const int n = r % (2 * DFE), k = r2 % DM, tile = n >> 8, wi = n & 255, sec = wi >> 7, c = tile * 128 + (wi & 127);
        ck_report(slot, bf2f(CKW(WS_MOE + MO_13)[((size_t)e * 2 * DFE + n) * DM + k]), rbf((sec ? P.in[I_M3] : P.in[I_M1])[(((size_t)mi * NE + e) * DM + k) * DFE + c]), 1e-6f, 1e-6f); }
      { const int n = r % DM, k = r2 % DFE; ck_report(slot, bf2f(CKW(WS_MOE + MO_2)[((size_t)e * DM + n) * DFE + k]), rbf(P.in[I_M2][(((size_t)mi * NE + e) * DFE + k) * DM + n]), 1e-6f, 1e-6f); } }
}
__device__ __forceinline__ const float* ck_xrow(const CkP& P, int row, bool first) {
    return row >= NLAT ? (first ? P.in[I_CTX] : (const float*)(P.ws + WS_XC)) + (size_t)(row - NLAT) * DM : (first ? P.in[I_X] : P.out) + (size_t)row * DM;
}
__global__ void ck_norm(CkP P, int l, int mode, int nrows, bool first, unsigned* slot) {
    const unsigned t = blockIdx.x * blockDim.x + threadIdx.x; const int row = hsh(t * 11 + 3) % nrows; const float* x = ck_xrow(P, row, first);
    double ss = 0; for (int k = 0; k < DM; ++k) ss += (double)x[k] * x[k];
    const float rstd = 1.0f / sqrtf((float)(ss / DM) + EPS); const int b = row >= NLAT ? 16 : row >> 12;
    const float* modl = (const float*)(P.ws + WS_MOD) + ((size_t)l * 17 + b) * 6144; const float* g = (mode == 0 ? P.in[I_N1G] : P.in[I_N2G]) + l * DM;
    for (int j = 0; j < 16; ++j) { const int c = hsh(t * 16 + j) % DM; const float h = x[c] * rstd * g[c] * (1.0f + modl[(mode == 0 ? 1024 : 4096) + c]) + modl[(mode == 0 ? 0 : 3072) + c];
        ck_report(slot, bf2f(((const bf16_t*)(P.ws + WS_H))[(size_t)row * DM + c]), h, 1e-2f, 1e-2f); }
}
__global__ void ck_win(CkP P, int l, unsigned* slot) {
    const unsigned t = blockIdx.x * blockDim.x + threadIdx.x; const unsigned r = hsh(t * 13 + 7);
    const int row = r % NTOK; int n = hsh(r) % D_IN; if (t & 1) n = ZR + (hsh(r) % 32);
    const bf16_t* H = (const bf16_t*)(P.ws + WS_H) + (size_t)row * DM; const bf16_t* W = CKW(WS_WSM + (size_t)l * SM_BYTES + SM_IN);
    auto dot = [&](int nn) { float a = 0; for (int k = 0; k < DM; ++k) a += bf2f(H[k]) * bf2f(W[(size_t)nn * DM + k]); return a; };
    float ref = dot(n);
    if (n < 768) ref = gelu_ref(ref);
    if (n >= ZR && row < NLAT) { const int pp = n - ZR, half = pp >> 4, i = (pp & 15) >> 1, s = pp & 1; const float other = dot(n ^ 1); const float x1 = s ? other : ref, x2 = s ? ref : other;
        const int tt = row & (SEQ - 1), pos = half ? (tt & 63) : (tt >> 6); const float ang = (float)pos * powf(10000.0f, -(float)(2 * i) / 16.0f); const float c = cosf(ang), sn = sinf(ang);
        ref = s ? (x1 * sn + x2 * c) : (x1 * c - x2 * sn); }
    ck_report(slot, bf2f(((const bf16_t*)(P.ws + WS_BIG + BG_ZIN))[(size_t)row * ZP + n]), ref, 2e-2f, 2e-2f);
}
__global__ void ck_qkv(CkP P, int l, unsigned* slotq, unsigned* slotkv) {
    const unsigned t = blockIdx.x * blockDim.x + threadIdx.x; const unsigned r = hsh(t * 17 + 9);
    const int row = r % NTOK; const bf16_t* Z = (const bf16_t*)(P.ws + WS_BIG + BG_ZIN) + (size_t)row * ZP;
    { double ss = 0; for (int k = 0; k < QLORA; ++k) { const float v = bf2f(Z[ZQ + k]); ss += (double)v * v; } const float rstd = 1.0f / sqrtf((float)(ss / QLORA) + EPS);
      const int h = hsh(r + 1) % HC, e = (t & 1) ? 64 + hsh(r + 2) % 32 : hsh(r + 2) % 64;
      auto qd = [&](int c) { float a = 0; for (int k = 0; k < QLORA; ++k) a += bf2f(Z[ZQ + k]) * rstd * P.in[I_QN][l * QLORA + k] * P.in[I_WUQ][((size_t)l * QLORA + k) * QP + c]; return a; };
      float ref; int nst;
      if (e < 64) { ref = qd(h * DQK + e); nst = h * DQK + e; }
      else { const int p = e - 64, half = p >> 4, w = p & 15, s = w >> 3, i = w & 7; const float x1 = qd(h * DQK + 64 + half * 16 + i), x2 = qd(h * DQK + 64 + half * 16 + 8 + i);
        if (row < NLAT) { const int tt = row & (SEQ - 1), pos = half ? (tt & 63) : (tt >> 6); const float ang = (float)pos * powf(10000.0f, -(float)(2 * i) / 16.0f); const float c = cosf(ang), sn = sinf(ang);
            ref = s ? (x1 * sn + x2 * c) : (x1 * c - x2 * sn); } else ref = s ? x2 : x1;
        nst = h * DQK + 64 + half * 16 + 2 * i + s; }
      ck_report(slotq, bf2f(((const bf16_t*)(P.ws + WS_BIG + BG_Q))[(size_t)row * QP + nst]), ref * QSCALE, 2e-2f * QSCALE, 2e-2f); }
    { double ss = 0; for (int k = 0; k < KVLORA; ++k) { const float v = bf2f(Z[ZKV + k]); ss += (double)v * v; } const float rstd = 1.0f / sqrtf((float)(ss / KVLORA) + EPS);
      const int n = hsh(r + 3) % KVP; float a = 0;
      for (int k = 0; k < KVLORA; ++k) a += bf2f(Z[ZKV + k]) * rstd * P.in[I_KVN][l * KVLORA + k] * (n < 512 ? P.in[I_WUK][((size_t)l * KVLORA + k) * 512 + n] : P.in[I_WUV][((size_t)l * KVLORA + k) * 512 + n - 512]);
      ck_report(slotkv, bf2f(((const bf16_t*)(P.ws + WS_BIG + BG_KV))[(size_t)row * KVP + n]), a, 2e-2f, 2e-2f); }
}
__global__ void ck_sgu(CkP P, int l, int ntok, unsigned* slot) {
    const unsigned t = blockIdx.x * blockDim.x + threadIdx.x; const unsigned r = hsh(t * 19 + 11);
    const int tok = r % ntok, ch = hsh(r) % 256, h = ch >> 6, p = tok & 127, tok0 = tok - p; const bf16_t* Z = (const bf16_t*)(P.ws + WS_BIG + BG_ZIN);
    float s = 0;
    for (int q = 0; q < 128; ++q) { const bf16_t* zr = Z + (size_t)(tok0 + q) * ZP + ZV; double m = 0, v2 = 0; for (int c = 0; c < 256; ++c) m += bf2f(zr[c]); m /= 256;
        for (int c = 0; c < 256; ++c) { const double d = bf2f(zr[c]) - m; v2 += d * d; } const float vn = (float)((bf2f(zr[ch]) - m) / sqrt(v2 / 256 + EPS)) * P.in[I_SLNG][l * 256 + ch] + P.in[I_SLNB][l * 256 + ch];
        s += P.in[I_SGUW][(((size_t)l * 4 + h) * 128 + p) * 128 + q] * vn; }
    s += P.in[I_SGUB][(l * 4 + h) * 128 + p];
    ck_report(slot, bf2f(((const bf16_t*)(P.ws + WS_BIG + BG_MIX))[(size_t)tok * DM + ch]), bf2f(Z[(size_t)tok * ZP + ZU + ch]) * s, 3e-2f, 3e-2f);
}
__global__ void ck_lru(CkP P, int l, bool last, unsigned* slot, float* tmp) {
    const unsigned t = blockIdx.x * blockDim.x + threadIdx.x; const unsigned r = hsh(t * 23 + 13);
    const int b = r % NB, ch = hsh(r) % 256, hh = ch >> 6, j = ch & 63; const bf16_t* Z = (const bf16_t*)(P.ws + WS_BIG + BG_ZIN);
    float* hf = tmp + (size_t)t * (SEQ + LC);
    auto rowof = [&](int pos) { return pos < LC ? NLAT + b * LC + pos : b * SEQ + (pos - LC); };
    auto xconv = [&](int pos, int c) { const bool isl = pos >= LC; const int tt = isl ? pos - LC : pos, len = isl ? SEQ : LC; float a = P.in[I_CONVB][l * 256 + c];
        for (int k = 0; k < 4; ++k) { const int ts = tt + k - 2; if (ts >= 0 && ts < len) a += P.in[I_CONVW][(l * 4 + k) * 256 + c] * bf2f(Z[(size_t)rowof(isl ? LC + ts : ts) * ZP + ZX + c]); } return a; };
    for (int d = 0; d < 2; ++d) {
        float h = 0.f; const float sp = log1pf(expf(-P.in[I_LAM][(l * 2 + d) * 256 + ch]));
        for (int step = 0; step < SEQ + LC; ++step) {
            const int pos = d == 0 ? step : (step < LC ? LC - 1 - step : LC + SEQ - 1 - (step - LC));
            float pa = P.in[I_LBA][(l * 2 + d) * 256 + ch], px = P.in[I_LBX][(l * 2 + d) * 256 + ch];
            for (int i = 0; i < 64; ++i) { const float xv = xconv(pos, hh * 64 + i); pa += xv * P.in[I_LWA][((((size_t)l * 2 + d) * 4 + hh) * 64 + i) * 64 + j]; px += xv * P.in[I_LWX][((((size_t)l * 2 + d) * 4 + hh) * 64 + i) * 64 + j]; }
            const float ra = 1.0f / (1.0f + expf(-pa)), ix = 1.0f / (1.0f + expf(-px)), la = -8.0f * ra * sp, a = expf(la), bv = sqrtf(-expm1f(2.0f * la)) * ix * xconv(pos, ch);
            h = a * h + bv;
            if (d == 0) hf[pos] = h;
            else if (pos >= LC || !last) { const int row = rowof(pos); ck_report(slot, bf2f(((const bf16_t*)(P.ws + WS_BIG + BG_MIX))[(size_t)row * DM + 256 + ch]), bf2f(Z[(size_t)row * ZP + ZG + ch]) * (hf[pos] + h), 3e-2f, 3e-2f); }
        }
    }
}
__global__ void ck_attn(CkP P, bool last, unsigned* slot) {
    const unsigned t = blockIdx.x * blockDim.x + threadIdx.x; const unsigned r = hsh(t * 29 + 17);
    const int row = r % (last ? NLAT : NTOK), h = hsh(r) % HC, d = hsh(r + 5) % 64; const bool cq = row >= NLAT; const int b = cq ? (row - NLAT) >> 8 : row >> 12;
    const bf16_t* Q = (const bf16_t*)(P.ws + WS_BIG + BG_Q) + (size_t)row * QP + h * DQK; const bf16_t* KV = (const bf16_t*)(P.ws + WS_BIG + BG_KV); const bf16_t* Z = (const bf16_t*)(P.ws + WS_BIG + BG_ZIN);
    const int nk = cq ? LC : SEQ + LC; double mx = -1e30, den = 0, num = 0;
    for (int pass = 0; pass < 2; ++pass) for (int kx = 0; kx < nk; ++kx) {
        const int kr = cq ? NLAT + b * LC + kx : (kx < SEQ ? b * SEQ + kx : NLAT + b * LC + kx - SEQ); double s = 0;
        for (int e = 0; e < 64; ++e) s += (double)bf2f(Q[e]) * bf2f(KV[(size_t)kr * KVP + h * 64 + e]);
        for (int e = 0; e < 32; ++e) s += (double)bf2f(Q[64 + e]) * bf2f(Z[(size_t)kr * ZP + ZR + e]);
        s *= 0.6931471805599453;
        if (pass == 0) mx = s > mx ? s : mx; else { const double pe = exp(s - mx); den += pe; num += pe * bf2f(KV[(size_t)kr * KVP + 512 + h * 64 + d]); } }
    ck_report(slot, bf2f(((const bf16_t*)(P.ws + WS_BIG + BG_MIX))[(size_t)row * DM + 512 + h * 64 + d]), (float)(num / den), 2e-2f, 3e-2f);
}
constexpr int NSNAP = 64;
__device__ __forceinline__ int snap_row(int s, int nrows) { return hsh(s * 31 + 19) % nrows; }
__global__ void ck_snap(CkP P, int nrows, bool first, float* snap) { const int s = blockIdx.x; const float* x = ck_xrow(P, snap_row(s, nrows), first); for (int c = threadIdx.x; c < DM; c += blockDim.x) snap[s * DM + c] = x[c]; }
__global__ void ck_res(CkP P, int l, int nrows, const bf16_t* A, int lda, int K, const float* W, int gate_off, const float* snap, unsigned* slot) {
    const int s = blockIdx.x, row = snap_row(s, nrows), c = hsh(s * 64 + threadIdx.x) % DM, b = row >= NLAT ? 16 : row >> 12;
    float a = 0; for (int k = 0; k < K; ++k) a += bf2f(A[(size_t)row * lda + k]) * W[(size_t)k * DM + c];
    const float ref = snap[s * DM + c] + ((const float*)(P.ws + WS_MOD))[((size_t)l * 17 + b) * 6144 + gate_off + c] * a;
    ck_report(slot, ck_xrow(P, row, false)[c], ref, 1e-2f, 1e-2f);
}
__global__ void ck_router(CkP P, int l, int nrows, unsigned* slot) {
    const unsigned t = blockIdx.x * blockDim.x + threadIdx.x; const int row = hsh(t * 37 + 23) % nrows, b = row >= NLAT ? 16 : row >> 12; const float* x = ck_xrow(P, row, false);
    double ss = 0; for (int k = 0; k < DM; ++k) ss += (double)x[k] * x[k]; const float rstd = 1.0f / sqrtf((float)(ss / DM) + EPS);
    const float* modl = (const float*)(P.ws + WS_MOD) + ((size_t)l * 17 + b) * 6144; double lg[NE] = {0, 0, 0, 0, 0, 0, 0, 0};
    for (int k = 0; k < DM; ++k) { const float h = x[k] * rstd * P.in[I_N2G][l * DM + k] * (1.0f + modl[4096 + k]) + modl[3072 + k]; for (int e = 0; e < NE; ++e) lg[e] += (double)h * P.in[I_ROUT][((size_t)(l >> 1) * DM + k) * NE + e]; }
    int e0 = 0; for (int e = 1; e < NE; ++e) if (lg[e] > lg[e0]) e0 = e; int e1 = e0 == 0 ? 1 : 0; for (int e = 0; e < NE; ++e) if (e != e0 && lg[e] > lg[e1]) e1 = e;
    double srt[NE]; for (int e = 0; e < NE; ++e) srt[e] = lg[e]; for (int i = 0; i < NE; ++i) for (int j = i + 1; j < NE; ++j) if (srt[j] > srt[i]) { const double tt = srt[i]; srt[i] = srt[j]; srt[j] = tt; }
    const int4 ep = *(const int4*)(P.ws + WS_TOPE + (size_t)row * 16); const f32x2 gg = *(const f32x2*)(P.ws + WS_TOPG + (size_t)row * 8);
    if (srt[1] - srt[2] > 1e-3 && srt[0] - srt[1] > 1e-3) { ck_report(slot, (float)ep.x, (float)e0, 0.5f, 0.f); ck_report(slot, (float)ep.z, (float)e1, 0.5f, 0.f);
        const double ex = exp(lg[e1] - lg[e0]); ck_report(slot, gg[0], (float)(1.0 / (1.0 + ex)), 2e-3f, 0.f); ck_report(slot, gg[1], (float)(ex / (1.0 + ex)), 2e-3f, 0.f); }
    const int* list = (const int*)(P.ws + WS_LIST); const unsigned* cnt = (const unsigned*)(P.ws + WS_CTL) + CW_CNT + (l >> 1) * NE * 64;
    ck_report(slot, (float)list[(size_t)ep.x * NTOK + ep.y], (float)row, 0.5f, 0.f); ck_report(slot, (float)list[(size_t)ep.z * NTOK + ep.w], (float)row, 0.5f, 0.f);
    ck_report(slot, (ep.y < (int)cnt[ep.x * 64] && ep.w < (int)cnt[ep.z * 64]) ? 0.f : 1.f, 0.f, 0.5f, 0.f);
    if (t == 0) { unsigned tot = 0; for (int e = 0; e < NE; ++e) tot += cnt[e * 64]; ck_report(slot, (float)tot, (float)(2 * nrows), 0.5f, 0.f); }
}
__global__ void ck_ffn_up(CkP P, int l, int nrows, unsigned* slot) {
    const unsigned t = blockIdx.x * blockDim.x + threadIdx.x; const unsigned r = hsh(t * 41 + 29); const int row = r % nrows, c = hsh(r) % DFF, i = l >> 1;
    const bf16_t* H = (const bf16_t*)(P.ws + WS_H) + (size_t)row * DM; float a = 0, g = 0;
    for (int k = 0; k < DM; ++k) { a += bf2f(H[k]) * P.in[I_F1][((size_t)i * DM + k) * DFF + c]; g += bf2f(H[k]) * P.in[I_F3][((size_t)i * DM + k) * DFF + c]; }
    ck_report(slot, bf2f(((const bf16_t*)(P.ws + WS_BIG + BG_HMID))[(size_t)row * DFF + c]), silu_ref(a) * g, 2e-2f, 3e-2f);
}
__global__ void ck_moe(CkP P, int l, int r, int which, unsigned* slot) {
    const unsigned t = blockIdx.x * blockDim.x + threadIdx.x; const unsigned rr = hsh(t * 43 + 31 + r); const int mi = l >> 1;
    const unsigned* cnt = (const unsigned*)(P.ws + WS_CTL) + CW_CNT + mi * NE * 64; int tp[NE + 1]; int acc = 0; for (int e = 0; e < NE; ++e) { tp[e] = acc; acc += ((int)cnt[e * 64] + 255) >> 8; } tp[NE] = acc;
    const int pm0 = r * MOE_RT, nM = min(max(acc - pm0, 0), MOE_RT); if (nM == 0) return;
    const int gpm = pm0 + rr % nM; int e = 0; for (int j = 1; j < NE; ++j) if (gpm >= tp[j]) e = j;
    const int pos = (gpm - tp[e]) * 256 + hsh(rr) % 256; const int tok = pos < (int)cnt[e * 64] ? ((const int*)(P.ws + WS_LIST))[(size_t)e * NTOK + pos] : 0;
    const size_t lrow = (size_t)(gpm - pm0) * 256 + (pos & 255);
    if (which == 0) { const int c = hsh(rr + 7) % DFE; const bf16_t* H = (const bf16_t*)(P.ws + WS_H) + (size_t)tok * DM; float a = 0, g = 0;
        for (int k = 0; k < DM; ++k) { a += bf2f(H[k]) * P.in[I_M1][(((size_t)mi * NE + e) * DM + k) * DFE + c]; g += bf2f(H[k]) * P.in[I_M3][(((size_t)mi * NE + e) * DM + k) * DFE + c]; }
        ck_report(slot, bf2f(((const bf16_t*)(P.ws + WS_BIG + BG_HMID))[lrow * DFE + c]), silu_ref(a) * g, 2e-2f, 3e-2f);
    } else { const int c = hsh(rr + 7) % DM; const bf16_t* A = (const bf16_t*)(P.ws + WS_BIG + BG_HMID) + lrow * DFE; float a = 0;
        for (int k = 0; k < DFE; ++k) a += bf2f(A[k]) * P.in[I_M2][(((size_t)mi * NE + e) * DFE + k) * DM + c];
        ck_report(slot, bf2f(((const bf16_t*)(P.ws + WS_BIG + BG_YPAD))[((size_t)gpm * 256 + (pos & 255)) * DM + c]), a, 2e-2f, 3e-2f); }
}
__global__ void ck_combine(CkP P, int lprev, int nrows, const float* snap, unsigned* slot) {
    const int s = blockIdx.x, row = snap_row(s, nrows), c = hsh(s * 64 + threadIdx.x + 1) % DM, b = row >= NLAT ? 16 : row >> 12, mi = lprev >> 1;
    const unsigned* cnt = (const unsigned*)(P.ws + WS_CTL) + CW_CNT + mi * NE * 64; int tp[NE + 1]; int acc = 0; for (int e = 0; e < NE; ++e) { tp[e] = acc; acc += ((int)cnt[e * 64] + 255) >> 8; }
    const int4 ep = *(const int4*)(P.ws + WS_TOPE + (size_t)row * 16); const f32x2 gg = *(const f32x2*)(P.ws + WS_TOPG + (size_t)row * 8); const bf16_t* Y = (const bf16_t*)(P.ws + WS_BIG + BG_YPAD);
    const float y = gg[0] * bf2f(Y[((size_t)tp[ep.x] * 256 + ep.y) * DM + c]) + gg[1] * bf2f(Y[((size_t)tp[ep.z] * 256 + ep.w) * DM + c]);
    ck_report(slot, ck_xrow(P, row, false)[c], snap[s * DM + c] + ((const float*)(P.ws + WS_MOD))[((size_t)lprev * 17 + b) * 6144 + 5120 + c] * y, 1e-3f, 1e-3f);
}
__global__ void ck_final(float* out, int n, const unsigned* chk, int nslots) {
    __shared__ int bad; if (threadIdx.x == 0) { bad = 0; for (int i = 1; i < nslots; ++i) if (__uint_as_float(chk[i]) > 1.0f) { bad = i; break; } } __syncthreads();
    if (bad == 0) return; const float c = sqrtf((float)bad * 1.0025f);
    for (int i = blockIdx.x * blockDim.x + threadIdx.x; i < n; i += gridDim.x * blockDim.x) out[i] = c;
}
#ifndef CK_ONLY
#define CK_ONLY 0
#endif
__global__ void ck_mag(float* out, int n, const unsigned* chk, int id) {
    const float e = __uint_as_float(chk[id]); const float c = sqrtf(fminf(e, 1e6f) * 1.0025f);
    for (int i = blockIdx.x * blockDim.x + threadIdx.x; i < n; i += gridDim.x * blockDim.x) out[i] = c;
}

static void run_checked(Params p, int grid, hipStream_t stream);
#endif
#if CHECK
static void run_checked(Params p, int grid, hipStream_t stream) {
    CkP c{}; for (int i = 0; i < N_IN; ++i) c.in[i] = p.in[i]; c.out = p.out; c.ws = p.ws;
    unsigned* chk = (unsigned*)(p.ws + WS_CTL) + CW_CHK;
    float* snap = (float*)(p.ws + WS_END + 4096); float* ltmp = snap + NSNAP * DM;
    auto run = [&](int s) { Params q = p; q.ph_lo = s; q.ph_hi = s + 1; hipLaunchKernelGGL(mega_fwd, dim3(grid), dim3(NTHR), LDS_BYTES, stream, q); };
#define SLOT(type, l) (chk + (type) * 4 + (l))
    run(0);
    ck_mod<<<4, 64, 0, stream>>>(c, SLOT(1, 0));
    for (int l = 0; l < DEPTH; ++l) ck_wcvt<<<16, 64, 0, stream>>>(c, l, 0, SLOT(2, l));
    for (int l = 0; l < DEPTH; ++l) {
        const int s0 = 1 + l * NPH; const bool last = l == DEPTH - 1, moe = l & 1; const int nrows = last ? NLAT : NTOK;
        if (l == 2) ck_snap<<<NSNAP, 64, 0, stream>>>(c, NTOK, false, snap);
        run(s0 + 0);
        if (l == 2) { ck_combine<<<NSNAP, 64, 0, stream>>>(c, 1, NTOK, snap, SLOT(19, 1)); ck_wcvt<<<16, 64, 0, stream>>>(c, l, 1, SLOT(2, l)); }
        ck_norm<<<2, 64, 0, stream>>>(c, l, 0, NTOK, l == 0, SLOT(3, l));
        run(s0 + 1); ck_win<<<8, 64, 0, stream>>>(c, l, SLOT(4, l));
        run(s0 + 2); ck_qkv<<<8, 64, 0, stream>>>(c, l, SLOT(5, l), SLOT(6, l)); ck_sgu<<<4, 64, 0, stream>>>(c, l, last ? NLAT : NTOK, SLOT(7, l));
        run(s0 + 3); ck_attn<<<4, 64, 0, stream>>>(c, last, SLOT(10, l));
        run(s0 + 4); ck_lru<<<1, 32, 0, stream>>>(c, l, last, SLOT(11, l), ltmp);
        ck_snap<<<NSNAP, 64, 0, stream>>>(c, nrows, l == 0, snap);
        run(s0 + 5); ck_res<<<NSNAP, 64, 0, stream>>>(c, l, nrows, (const bf16_t*)(p.ws + WS_BIG + BG_MIX), DM, DM, p.in[I_WOUT] + (size_t)l * DM * DM, 2048, snap, SLOT(12, l));
        run(s0 + 6); ck_norm<<<2, 64, 0, stream>>>(c, l, 1, nrows, false, SLOT(13, l));
        if (!moe) {
            run(s0 + 7); ck_ffn_up<<<8, 64, 0, stream>>>(c, l, nrows, SLOT(15, l));
            ck_snap<<<NSNAP, 64, 0, stream>>>(c, nrows, false, snap);
            run(s0 + 8); ck_res<<<NSNAP, 64, 0, stream>>>(c, l, nrows, (const bf16_t*)(p.ws + WS_BIG + BG_HMID), DFF, DFF, p.in[I_F2] + (size_t)(l >> 1) * DFF * DM, 5120, snap, SLOT(16, l));
        } else {
            ck_router<<<4, 64, 0, stream>>>(c, l, nrows, SLOT(14, l));
            for (int r = 0; r < MOE_NR; ++r) { run(s0 + 7 + 2 * r); ck_moe<<<8, 64, 0, stream>>>(c, l, r, 0, SLOT(17, l)); run(s0 + 8 + 2 * r); ck_moe<<<8, 64, 0, stream>>>(c, l, r, 1, SLOT(18, l)); }
        }
    }
    run(NSTEPS - 1);
#if CK_ONLY
    ck_mag<<<1024, 256, 0, stream>>>(p.out, NLAT * DM, chk, CK_ONLY);
#else
    ck_final<<<1024, 256, 0, stream>>>(p.out, NLAT * DM, chk, 80);
#endif
#undef SLOT
}
#endif

extern "C" void kernel_launch(void* const* d_in, const int* in_sizes, int n_in, void* d_out, int out_size, void* d_ws, size_t ws_size, hipStream_t stream) {
    static int grid = 0;
    if (grid == 0) {
        if (n_in != N_IN || in_sizes[0] != NLAT * DM || out_size != NLAT * DM || ws_size < WS_END + (CHECK ? (8u << 20) : 0)) {
            fprintf(stderr, "kernel_launch: shape mismatch: n_in %d in0 %d out %d ws %zu (need %zu)\n", n_in, n_in > 0 ? in_sizes[0] : -1, out_size, ws_size, (size_t)WS_END); grid = -1; return; }
        int dev = 0, cus = 0, per_cu = 0;
        if (hipGetDevice(&dev) != hipSuccess || hipDeviceGetAttribute(&cus, hipDeviceAttributeMultiprocessorCount, dev) != hipSuccess) { grid = -1; return; }
        if (hipFuncSetAttribute((const void*)mega_fwd, hipFuncAttributeMaxDynamicSharedMemorySize, LDS_BYTES) != hipSuccess) { fprintf(stderr, "kernel_launch: hipFuncSetAttribute failed\n"); grid = -1; return; }
        if (hipOccupancyMaxActiveBlocksPerMultiprocessor(&per_cu, (const void*)mega_fwd, NTHR, LDS_BYTES) != hipSuccess || per_cu < 1) { fprintf(stderr, "kernel_launch: occupancy query says %d\n", per_cu); }
        (void)hipGetLastError();
        grid = cus;
    }
    if (grid < 0) return;
    (void)hipMemsetAsync((char*)d_ws + WS_CTL, 0, CHECK ? CTL_BYTES : (size_t)CW_CHK * 4, stream);
    Params p{};
    for (int i = 0; i < N_IN; ++i) p.in[i] = (const float*)d_in[i];
    p.out = (float*)d_out; p.ws = (unsigned char*)d_ws;
#if CHECK
    run_checked(p, grid, stream);
#else
    p.ph_lo = 0; p.ph_hi = NSTEPS;
    hipLaunchKernelGGL(mega_fwd, dim3(grid), dim3(NTHR), LDS_BYTES, stream, p);
#endif
}
```
